# Optimizing an MI355X kernel written in HIP

```python
import math
import jax
import jax.numpy as jnp
from jax import lax
import numpy as np

D_MODEL = 1024
BATCH = 4
SEQ = 4096
DEPTH = 1

POOL_WINDOWS = (2, 4, 8, 16)
POOL_GROUPS = 4
POOL_GROUP_DIM = D_MODEL // 8
POOL_WIDTH = POOL_GROUPS * POOL_GROUP_DIM
HEAD_DIM = 64
ATT_PATTERNS = ((128, 1), (512, 4), (2048, 16))
HEADS_PER_GROUP = 4
N_ATT_HEADS = HEADS_PER_GROUP * len(ATT_PATTERNS)
ATT_WIDTH = N_ATT_HEADS * HEAD_DIM
ATT_OUT_WIDTH = HEADS_PER_GROUP * HEAD_DIM
ALIBI_MAX_BIAS = 8.0
ATT_BLOCK = 128
IN_WIDTH = POOL_WIDTH + 3 * ATT_WIDTH + 2 * D_MODEL
N_EXPERT_GROUPS = 4
EXPERTS_PER_GROUP = 8
N_EXPERTS = N_EXPERT_GROUPS * EXPERTS_PER_GROUP
EXPERT_TOPK = 2
D_EXPERT = D_MODEL // 2
MOE_BLOCK = 128
RMS_EPS = 1e-6

kernel_name = 'hybrid_pool_dilated_attn_hmoe_block'


def _rmsnorm(x, g):
    xf = x.astype(jnp.float32)
    y = xf * lax.rsqrt(jnp.mean(xf * xf, axis=-1, keepdims=True) + RMS_EPS)
    return (y * g.astype(jnp.float32)).astype(x.dtype)


def _alibi_slopes():
    h = jnp.arange(1, N_ATT_HEADS + 1, dtype=jnp.float32)
    return jnp.exp2(-ALIBI_MAX_BIAS * h / N_ATT_HEADS)


def _multiscale_pool(u):
    b, s, _ = u.shape
    ug = u.astype(jnp.float32).reshape(b, s, POOL_GROUPS, POOL_GROUP_DIM)
    cs = jnp.cumsum(ug, axis=1)
    t = jnp.arange(s)
    outs = []
    for g, w in enumerate(POOL_WINDOWS):
        csg = cs[:, :, g]
        lagged = jnp.pad(csg[:, : s - w], ((0, 0), (w, 0), (0, 0)))
        count = jnp.minimum(t + 1, w).astype(jnp.float32)[None, :, None]
        outs.append((csg - lagged) / count - ug[:, :, g])
    return jnp.stack(outs, axis=2).astype(u.dtype)


def _dilated_window_attention(q, k, v, window, dilation, slopes):
    b, s, h, hd = q.shape
    sub_len = s // dilation
    nb = -(-sub_len // ATT_BLOCK)
    padded = nb * ATT_BLOCK
    reach = window // dilation

    def to_sub(t):
        t = t.reshape(b, sub_len, dilation, h, hd).transpose(0, 2, 3, 1, 4)
        return jnp.pad(t, ((0, 0), (0, 0), (0, 0), (0, padded - sub_len), (0, 0)))

    def key_blocks(t):
        t = jnp.pad(t, ((0, 0), (0, 0), (0, 0), (ATT_BLOCK, 0), (0, 0)))
        t = t.reshape(b, dilation, h, nb + 1, ATT_BLOCK, hd)
        return jnp.concatenate([t[:, :, :, :-1], t[:, :, :, 1:]], axis=4)

    qb = to_sub(q).reshape(b, dilation, h, nb, ATT_BLOCK, hd)
    kb = key_blocks(to_sub(k))
    vb = key_blocks(to_sub(v))
    scores = jnp.einsum('brhnqd,brhnkd->brhnqk', qb, kb,
                        preferred_element_type=jnp.float32) * (hd ** -0.5)
    qi = jnp.arange(ATT_BLOCK)[:, None]
    ki = jnp.arange(2 * ATT_BLOCK)[None, :]
    delta = ATT_BLOCK + qi - ki
    key_sub = (jnp.arange(nb)[:, None, None] - 1) * ATT_BLOCK + ki[None]
    valid = (delta >= 0) & (delta <= reach) & (key_sub >= 0)
    bias = -slopes[:, None, None] * (delta * dilation).astype(jnp.float32)
    scores = jnp.where(valid[None, None, None], scores + bias[None, None, :, None], -jnp.inf)
    mx = jnp.max(scores, axis=-1, keepdims=True)
    p = jnp.exp(scores - mx)
    den = jnp.sum(p, axis=-1, keepdims=True)
    o = jnp.einsum('brhnqk,brhnkd->brhnqd', p, vb.astype(jnp.float32)) / den
    lse = (mx + jnp.log(den))[..., 0]
    o = o.reshape(b, dilation, h, padded, hd)[:, :, :, :sub_len]
    o = o.transpose(0, 3, 1, 2, 4).reshape(b, s, h, hd)
    lse = lse.reshape(b, dilation, h, padded)[..., :sub_len]
    lse = lse.transpose(0, 3, 1, 2).reshape(b, s, h)
    return o, lse


def _token_mixer(h, w_in, w_pool_group, pool_scale, w_branch_pool, w_branch_att, w_out):
    b, s, _ = h.shape
    proj = h @ w_in
    splits = [POOL_WIDTH, POOL_WIDTH + ATT_WIDTH, POOL_WIDTH + 2 * ATT_WIDTH,
              POOL_WIDTH + 3 * ATT_WIDTH, POOL_WIDTH + 3 * ATT_WIDTH + D_MODEL]
    u, q, k, v, gate_pool, gate_att = jnp.split(proj, splits, axis=-1)

    pooled = _multiscale_pool(u)
    pooled = jnp.einsum('bsgc,gcd->bsgd', pooled, w_pool_group).reshape(b, s, POOL_WIDTH)
    y_pool = (pooled * pool_scale) @ w_branch_pool

    q = q.reshape(b, s, N_ATT_HEADS, HEAD_DIM)
    k = k.reshape(b, s, N_ATT_HEADS, HEAD_DIM)
    v = v.reshape(b, s, N_ATT_HEADS, HEAD_DIM)
    slopes = _alibi_slopes()
    outs, lses = [], []
    for g, (window, dilation) in enumerate(ATT_PATTERNS):
        hs = slice(g * HEADS_PER_GROUP, (g + 1) * HEADS_PER_GROUP)
        o, l = _dilated_window_attention(q[:, :, hs], k[:, :, hs], v[:, :, hs],
                                         window, dilation, slopes[hs])
        outs.append(o)
        lses.append(l)
    weights = jax.nn.softmax(jnp.stack(lses, axis=0), axis=0)
    o = jnp.sum(weights[..., None] * jnp.stack(outs, axis=0), axis=0)
    y_att = o.reshape(b, s, ATT_OUT_WIDTH).astype(h.dtype) @ w_branch_att

    merged = jax.nn.sigmoid(gate_pool) * y_pool + jax.nn.sigmoid(gate_att) * y_att
    return merged @ w_out


def _hier_moe(h, w_group_router, b_group_router, w_expert_router, b_expert_router,
              w_gate, w_up, w_down):
    t_count = h.shape[0]
    hf = h.astype(jnp.float32)
    g_logits = hf @ w_group_router.astype(jnp.float32) + b_group_router.astype(jnp.float32)
    g_prob = jax.nn.softmax(g_logits, axis=-1)
    g_sel = jnp.argmax(g_logits, axis=-1)
    p_group = jnp.take_along_axis(g_prob, g_sel[:, None], axis=1)[:, 0]
    e_logits = (hf @ w_expert_router.astype(jnp.float32)
                + b_expert_router.astype(jnp.float32)).reshape(t_count, N_EXPERT_GROUPS, EXPERTS_PER_GROUP)
    e_logits = jnp.take_along_axis(e_logits, g_sel[:, None, None], axis=1)[:, 0]
    top_v, top_i = lax.top_k(e_logits, EXPERT_TOPK)
    gate_w = p_group[:, None] * jax.nn.softmax(top_v, axis=-1)
    expert_id = g_sel[:, None] * EXPERTS_PER_GROUP + top_i

    n_assign = t_count * EXPERT_TOPK
    e_a = expert_id.reshape(-1).astype(jnp.int32)
    tok_a = jnp.repeat(jnp.arange(t_count, dtype=jnp.int32), EXPERT_TOPK)
    w_a = gate_w.reshape(-1)
    order = jnp.argsort(e_a)
    e_s, tok_s, w_s = e_a[order], tok_a[order], w_a[order]
    counts = jnp.zeros((N_EXPERTS,), jnp.int32).at[e_a].add(1)
    pad_counts = ((counts + MOE_BLOCK - 1) // MOE_BLOCK) * MOE_BLOCK
    pad_end = jnp.cumsum(pad_counts)
    pad_start = pad_end - pad_counts
    raw_start = jnp.cumsum(counts) - counts
    dest = pad_start[e_s] + jnp.arange(n_assign, dtype=jnp.int32) - raw_start[e_s]
    n_blocks = -(-n_assign // MOE_BLOCK) + N_EXPERTS
    n_slots = n_blocks * MOE_BLOCK
    slot_tok = jnp.zeros((n_slots,), jnp.int32).at[dest].set(tok_s)
    slot_w = jnp.zeros((n_slots,), h.dtype).at[dest].set(w_s.astype(h.dtype))
    block_start = jnp.arange(n_blocks, dtype=jnp.int32) * MOE_BLOCK
    block_expert = jnp.minimum(jnp.searchsorted(pad_end, block_start, side='right'),
                               N_EXPERTS - 1).astype(jnp.int32)

    def run_block(args):
        tok, e = args
        xb = h[tok]
        a = xb @ w_gate[e]
        u = xb @ w_up[e]
        return (jax.nn.silu(a) * u) @ w_down[e]

    y = lax.map(run_block, (slot_tok.reshape(n_blocks, MOE_BLOCK), block_expert))
    y = y.reshape(n_slots, D_MODEL) * slot_w[:, None]
    return jnp.zeros((t_count, D_MODEL), h.dtype).at[slot_tok].add(y)


def setup_inputs(seed: int = 0) -> dict:
    key = jax.random.key(seed)
    ks = jax.random.split(key, 24)
    f32 = jnp.float32
    L, D = DEPTH, D_MODEL

    def nrm(k, shape, scale):
        return jax.random.normal(k, shape, f32) * scale

    return {
        'x': nrm(ks[0], (BATCH, SEQ, D), 1.0),
        'c': nrm(ks[1], (BATCH, D), 1.0),
        'w_ada': nrm(ks[2], (L, D, 6 * D), 0.5 * D ** -0.5),
        'b_ada': nrm(ks[3], (L, 6 * D), 0.02),
        'g_pre_mix': 1.0 + nrm(ks[4], (L, D), 0.02),
        'g_post_mix': 1.0 + nrm(ks[5], (L, D), 0.02),
        'g_pre_ffn': 1.0 + nrm(ks[6], (L, D), 0.02),
        'g_post_ffn': 1.0 + nrm(ks[7], (L, D), 0.02),
        'w_in': nrm(ks[8], (L, D, IN_WIDTH), D ** -0.5),
        'w_pool_group': nrm(ks[9], (L, POOL_GROUPS, POOL_GROUP_DIM, POOL_GROUP_DIM), POOL_GROUP_DIM ** -0.5),
        'pool_scale': 1.0 + nrm(ks[10], (L, POOL_WIDTH), 0.02),
        'w_branch_pool': nrm(ks[11], (L, POOL_WIDTH, D), POOL_WIDTH ** -0.5),
        'w_branch_att': nrm(ks[12], (L, ATT_OUT_WIDTH, D), ATT_OUT_WIDTH ** -0.5),
        'w_out': nrm(ks[13], (L, D, D), D ** -0.5),
        'w_group_router': nrm(ks[14], (L, D, N_EXPERT_GROUPS), D ** -0.5),
        'b_group_router': nrm(ks[15], (L, N_EXPERT_GROUPS), 0.01),
        'w_expert_router': nrm(ks[16], (L, D, N_EXPERTS), D ** -0.5),
        'b_expert_router': nrm(ks[17], (L, N_EXPERTS), 0.01),
        'w_exp_gate': nrm(ks[18], (L, N_EXPERTS, D, D_EXPERT), D ** -0.5),
        'w_exp_up': nrm(ks[19], (L, N_EXPERTS, D, D_EXPERT), D ** -0.5),
        'w_exp_down': nrm(ks[20], (L, N_EXPERTS, D_EXPERT, D), D_EXPERT ** -0.5),
    }


def reference(x, c, w_ada, b_ada, g_pre_mix, g_post_mix, g_pre_ffn, g_post_ffn, w_in,
              w_pool_group, pool_scale, w_branch_pool, w_branch_att, w_out,
              w_group_router, b_group_router, w_expert_router, b_expert_router,
              w_exp_gate, w_exp_up, w_exp_down):
    b, s, d = x.shape
    for layer in range(DEPTH):
        mod = jax.nn.silu(c) @ w_ada[layer] + b_ada[layer]
        sh_m, sc_m, gt_m, sh_f, sc_f, gt_f = jnp.split(mod, 6, axis=-1)
        h = _rmsnorm(x, g_pre_mix[layer]) * (1.0 + sc_m[:, None]) + sh_m[:, None]
        y = _token_mixer(h, w_in[layer], w_pool_group[layer], pool_scale[layer],
                         w_branch_pool[layer], w_branch_att[layer], w_out[layer])
        x = x + gt_m[:, None] * _rmsnorm(y, g_post_mix[layer])
        h = _rmsnorm(x, g_pre_ffn[layer]) * (1.0 + sc_f[:, None]) + sh_f[:, None]
        y = _hier_moe(h.reshape(b * s, d), w_group_router[layer], b_group_router[layer],
                      w_expert_router[layer], b_expert_router[layer],
                      w_exp_gate[layer], w_exp_up[layer], w_exp_down[layer]).reshape(b, s, d)
        x = x + gt_f[:, None] * _rmsnorm(y, g_post_ffn[layer])
    return x
```

```cpp
#include <hip/hip_runtime.h>
#include <hip/hip_cooperative_groups.h>
#include <cstdio>
#include <cstdint>
namespace cg = cooperative_groups;

#define LAS __attribute__((address_space(3)))
#define GAS __attribute__((address_space(1)))
typedef unsigned short bf16_t;
typedef short bf16x8 __attribute__((ext_vector_type(8)));
typedef short s16x4 __attribute__((ext_vector_type(4)));
typedef float f32x4 __attribute__((ext_vector_type(4)));
typedef float f32x16 __attribute__((ext_vector_type(16)));
typedef float f32x2 __attribute__((ext_vector_type(2)));
typedef unsigned u32x4 __attribute__((ext_vector_type(4)));
typedef unsigned u32x2 __attribute__((ext_vector_type(2)));

constexpr int NB = 4, SEQ = 4096, DM = 1024, NT = NB * SEQ;
constexpr int POOLW = 512, ATTW = 768, NIN = 4864, NHEAD = 12, HD = 64;
constexpr int NEXP = 32, DEXP = 512;
constexpr float RMS_EPS = 1e-6f;
constexpr float LOG2E = 1.4426950408889634f;
constexpr int XS_ROWS = 40960;

__device__ __forceinline__ unsigned f2bf(float f) { unsigned u = __builtin_bit_cast(unsigned, f); return (u + 0x7fffu + ((u >> 16) & 1u)) >> 16; }
__device__ __forceinline__ unsigned pk2(float lo, float hi) { return f2bf(lo) | (f2bf(hi) << 16); }
__device__ __forceinline__ float bf_lo(unsigned w) { return __builtin_bit_cast(float, w << 16); }
__device__ __forceinline__ float bf_hi(unsigned w) { return __builtin_bit_cast(float, w & 0xffff0000u); }
template <int CTRL> __device__ __forceinline__ float dpp_mov(float v) { return __builtin_bit_cast(float, __builtin_amdgcn_update_dpp(0, __builtin_bit_cast(int, v), CTRL, 0xf, 0xf, true)); }
#ifndef SAFE_SUM
#define SAFE_SUM 1
#endif
__device__ __forceinline__ float bperm_xor(float v, int m) { int l; asm volatile("v_mbcnt_lo_u32_b32 %0, -1, 0\n\tv_mbcnt_hi_u32_b32 %0, -1, %0" : "=v"(l));
    return __builtin_bit_cast(float, __builtin_amdgcn_ds_bpermute((l ^ m) << 2, __builtin_bit_cast(int, v))); }
__device__ __forceinline__ float sum_xor16(float v) { if (SAFE_SUM) return v + bperm_xor(v, 16); auto r = __builtin_amdgcn_permlane16_swap(__builtin_bit_cast(unsigned, v), __builtin_bit_cast(unsigned, v), false, false); return __builtin_bit_cast(float, r[0]) + __builtin_bit_cast(float, r[1]); }
__device__ __forceinline__ float sum_xor32(float v) { if (SAFE_SUM) return v + bperm_xor(v, 32); auto r = __builtin_amdgcn_permlane32_swap(__builtin_bit_cast(unsigned, v), __builtin_bit_cast(unsigned, v), false, false); return __builtin_bit_cast(float, r[0]) + __builtin_bit_cast(float, r[1]); }
__device__ __forceinline__ float max_xor32(float v) { if (SAFE_SUM) return fmaxf(v, bperm_xor(v, 32)); auto r = __builtin_amdgcn_permlane32_swap(__builtin_bit_cast(unsigned, v), __builtin_bit_cast(unsigned, v), false, false); return fmaxf(__builtin_bit_cast(float, r[0]), __builtin_bit_cast(float, r[1])); }
__device__ __forceinline__ int lane_id_asm();
__device__ __forceinline__ float wave_sum_bperm(float v) {
    int l; asm volatile("v_mbcnt_lo_u32_b32 %0, -1, 0\n\tv_mbcnt_hi_u32_b32 %0, -1, %0" : "=v"(l));
#pragma unroll
    for (int m = 1; m < 64; m <<= 1) v += __builtin_bit_cast(float, __builtin_amdgcn_ds_bpermute((l ^ m) << 2, __builtin_bit_cast(int, v)));
    return v;
}
__device__ __forceinline__ float wave_sum_dpp(float v) {
    v += dpp_mov<0xB1>(v);
    v += dpp_mov<0x4E>(v);
    v += dpp_mov<0x141>(v);
    v += dpp_mov<0x140>(v);
    return sum_xor32(sum_xor16(v));
}
__device__ __forceinline__ float wave_sum(float v) { return SAFE_SUM ? wave_sum_bperm(v) : wave_sum_dpp(v); }
__device__ __forceinline__ int lane_id_asm() { int l; asm volatile("v_mbcnt_lo_u32_b32 %0, -1, 0\n\tv_mbcnt_hi_u32_b32 %0, -1, %0" : "=v"(l)); return l; }
__device__ __forceinline__ float sigmoidf_(float x) { return __builtin_amdgcn_rcpf(1.0f + __builtin_amdgcn_exp2f(-x * LOG2E)); }

#ifndef DIAG
#define DIAG 0
#endif
constexpr int DIAGV = DIAG;
namespace pg8 {
#define PG8_LAS __attribute__((address_space(3)))
constexpr int BM = 256, BK = 64, HALF = 128, HTB = HALF * BK * 2  , STAGE_BYTES = 8 * HTB, NXCD = 8, WGM = 8;

__host__ __device__ __forceinline__ int lds_byte(int r, int c) { const int st = (r >> 4) * 2 + (c >> 5), rr = r & 15, cc = c & 31, ob = rr * 64 + cc * 2; return st * 1024 + (ob ^ (((ob >> 9) & 1) << 5)); }
__host__ __device__ __forceinline__ void stage_rc(int b, int& R, int& C) { const int st = b / 1024, sb = b % 1024, swz = sb ^ (((sb >> 9) & 1) << 5); R = (st >> 1) * 16 + swz / 64; C = (st & 1) * 32 + (swz % 64) / 2; }
__host__ __device__ __forceinline__ int perm32(int rho) { const int n = rho >> 4, i = rho & 15; return 8 * (i >> 2) + 4 * n + (i & 3); }

struct Unit { int pm, pn; long boff; };
struct Gemm { const bf16_t* A; const bf16_t* Bt; int M, N, K; };

struct StaticOrder {
    int nM, nN, nwg, G, c;
    __host__ __device__ void init(int M, int N, int G_, int c_) { nM = M / BM; nN = N / BM; nwg = nM * nN; G = G_; c = c_; }
    __host__ __device__ bool next(int i, Unit& u) const {
        const long L = (long)i * G + c; if (L >= nwg) return false;
        int wgid = (int)L; { const int q = nwg / NXCD, r = nwg % NXCD, xcd = wgid % NXCD, off = wgid / NXCD; wgid = (xcd < r ? xcd * (q + 1) : r * (q + 1) + (xcd - r) * q) + off; }
        const int nig = WGM * nN, gid = wgid / nig, fm = gid * WGM, gsz = (nM - fm) < WGM ? (nM - fm) : WGM;
        u.pm = fm + ((wgid % nig) % gsz); u.pn = (wgid % nig) / gsz; u.boff = 0; return true;
    }
    __device__ __forceinline__ void a_ready(const Unit&) const {}
    __device__ __forceinline__ void done(const Unit&) const {}
};
__device__ __forceinline__ unsigned cvt_pk_bf16(float lo, float hi) { unsigned r; asm volatile("v_cvt_pk_bf16_f32 %0, %1, %2" : "=v"(r) : "v"(lo), "v"(hi)); return r; }


__device__ __forceinline__ u32x4 pack8(const f32x4& v0, const f32x4& v1) { u32x4 w; w.x = cvt_pk_bf16(v0[0], v0[1]); w.y = cvt_pk_bf16(v0[2], v0[3]); w.z = cvt_pk_bf16(v1[0], v1[1]); w.w = cvt_pk_bf16(v1[2], v1[3]); return w; }
__device__ __forceinline__ void unpack8(const u32x4& w, f32x4& v0, f32x4& v1) { v0[0] = bf_lo(w.x); v0[1] = bf_hi(w.x); v0[2] = bf_lo(w.y); v0[3] = bf_hi(w.y); v1[0] = bf_lo(w.z); v1[1] = bf_hi(w.z); v1[2] = bf_lo(w.w); v1[3] = bf_hi(w.w); }

struct EpiProj {
    static constexpr bool PERM = true, AFTER_DRAIN = false;
    bf16_t* U; bf16_t* QKV; bf16_t* G; float qscale;
    __device__ __forceinline__ void operator()(const f32x4 (&acc)[2][2][4][2], const Unit& u, int wr, int wc, int fr, int fq) const {
        const int pn = u.pn;
        const int row0 = u.pm * BM + wr * 64 + fr;
        const int cin0 = wc * 32 + 8 * fq;
        if (pn < 2 || pn >= 11) {
            bf16_t* base; int ldc, c0;
            if (pn < 2) { base = U; ldc = POOLW; c0 = pn * BM; } else { base = G; ldc = 2 * DM; c0 = (pn - 11) * BM; }
#pragma unroll
            for (int ai = 0; ai < 2; ++ai)
#pragma unroll
                for (int m = 0; m < 4; ++m) { bf16_t* rowp = base + (size_t)(row0 + ai * HALF + m * 16) * ldc + c0 + cin0;
#pragma unroll
                    for (int bj = 0; bj < 2; ++bj) *(u32x4*)(rowp + bj * HALF) = pack8(acc[ai][bj][m][0], acc[ai][bj][m][1]); }
        } else {
            const int which = (pn - 2) / 3, grp = (pn - 2) % 3, sh = 2 * grp;
            bf16_t* base = QKV + (size_t)which * ((size_t)NB * NHEAD * SEQ * HD);
            const float sc = which == 0 ? qscale : 1.0f;
            const int sublen = SEQ >> sh;
#pragma unroll
            for (int ai = 0; ai < 2; ++ai)
#pragma unroll
                for (int m = 0; m < 4; ++m) { const int row = row0 + ai * HALF + m * 16; const int b = row / SEQ, t = row % SEQ;
                    const int pos = (t & ((1 << sh) - 1)) * sublen + (t >> sh);
#pragma unroll
                    for (int bj = 0; bj < 2; ++bj) { const int cin = bj * HALF + cin0; const int head = grp * 4 + (cin >> 6), dcol = cin & 63;
                        bf16_t* dst = base + ((size_t)(b * NHEAD + head) * SEQ + pos) * HD + dcol;
                        *(u32x4*)dst = pack8(acc[ai][bj][m][0] * sc, acc[ai][bj][m][1] * sc); } }
        }
    }
};
struct EpiGate1 {
    static constexpr bool PERM = true, AFTER_DRAIN = false;
    const bf16_t* G; bf16_t* TMP;
    __device__ __forceinline__ void operator()(const f32x4 (&acc)[2][2][4][2], const Unit& u, int wr, int wc, int fr, int fq) const {
        const int row0 = u.pm * BM + wr * 64 + fr, col0 = u.pn * BM + wc * 32 + 8 * fq;
#pragma unroll
        for (int ai = 0; ai < 2; ++ai)
#pragma unroll
            for (int m = 0; m < 4; ++m) { const size_t row = (size_t)(row0 + ai * HALF + m * 16);
#pragma unroll
                for (int bj = 0; bj < 2; ++bj) { const int col = col0 + bj * HALF;
                    const u32x4 gw = *(const u32x4*)(G + row * (2 * DM) + col); f32x4 g0, g1; unpack8(gw, g0, g1);
                    f32x4 v0 = acc[ai][bj][m][0], v1 = acc[ai][bj][m][1];
#pragma unroll
                    for (int j = 0; j < 4; ++j) { v0[j] *= sigmoidf_(g0[j]); v1[j] *= sigmoidf_(g1[j]); }
                    *(u32x4*)(TMP + row * DM + col) = pack8(v0, v1); } }
    }
};
struct EpiGate2 {
    static constexpr bool PERM = true, AFTER_DRAIN = false;
    const bf16_t* G; const bf16_t* TMP; bf16_t* OUT;
    __device__ __forceinline__ void operator()(const f32x4 (&acc)[2][2][4][2], const Unit& u, int wr, int wc, int fr, int fq) const {
        const int row0 = u.pm * BM + wr * 64 + fr, col0 = u.pn * BM + wc * 32 + 8 * fq;
#pragma unroll
        for (int ai = 0; ai < 2; ++ai)
#pragma unroll
            for (int m = 0; m < 4; ++m) { const size_t row = (size_t)(row0 + ai * HALF + m * 16);
#pragma unroll
                for (int bj = 0; bj < 2; ++bj) { const int col = col0 + bj * HALF;
                    const u32x4 gw = *(const u32x4*)(G + row * (2 * DM) + DM + col); f32x4 g0, g1; unpack8(gw, g0, g1);
                    const u32x4 tw = *(const u32x4*)(TMP + row * DM + col); f32x4 t0, t1; unpack8(tw, t0, t1);
                    f32x4 v0 = acc[ai][bj][m][0], v1 = acc[ai][bj][m][1];
#pragma unroll
                    for (int j = 0; j < 4; ++j) { v0[j] = t0[j] + (DIAGV == 2 ? 0.f : 1.f) * v0[j] * sigmoidf_(g0[j]); v1[j] = t1[j] + (DIAGV == 2 ? 0.f : 1.f) * v1[j] * sigmoidf_(g1[j]); }
                    *(u32x4*)(OUT + row * DM + col) = pack8(v0, v1); } }
    }
};
struct EpiY {
    static constexpr bool PERM = true, AFTER_DRAIN = false;
    bf16_t* Y; float* YSTAT;
    __device__ __forceinline__ void operator()(const f32x4 (&acc)[2][2][4][2], const Unit& u, int wr, int wc, int fr, int fq) const {
        const int row0 = u.pm * BM + wr * 64 + fr, col0 = u.pn * BM + wc * 32 + 8 * fq;
#pragma unroll
        for (int ai = 0; ai < 2; ++ai)
#pragma unroll
            for (int m = 0; m < 4; ++m) { const size_t row = (size_t)(row0 + ai * HALF + m * 16); float s = 0.f;
#pragma unroll
                for (int bj = 0; bj < 2; ++bj) { const f32x4 v0 = acc[ai][bj][m][0], v1 = acc[ai][bj][m][1];
                    s += (v0[0] * v0[0] + v0[1] * v0[1]) + (v0[2] * v0[2] + v0[3] * v0[3]) + (v1[0] * v1[0] + v1[1] * v1[1]) + (v1[2] * v1[2] + v1[3] * v1[3]);
                    *(u32x4*)(Y + row * DM + col0 + bj * HALF) = pack8(v0, v1); }
                s = sum_xor32(sum_xor16(s));
                if (fq == 0) YSTAT[row * 16 + u.pn * 4 + wc] = s; }
    }
};
struct EpiAct {
    static constexpr bool PERM = true, AFTER_DRAIN = false;
    bf16_t* ACT;
    __device__ __forceinline__ void operator()(const f32x4 (&acc)[2][2][4][2], const Unit& u, int wr, int wc, int fr, int fq) const {
        const int row0 = u.pm * BM + wr * 64 + fr, col0 = u.pn * 128 + wc * 16 + 4 * fq;
#pragma unroll
        for (int ai = 0; ai < 2; ++ai)
#pragma unroll
            for (int m = 0; m < 4; ++m) { const size_t row = (size_t)(row0 + ai * HALF + m * 16);
#pragma unroll
                for (int bj = 0; bj < 2; ++bj) { const f32x4 g = acc[ai][bj][m][0], up = acc[ai][bj][m][1]; float a[4];
#pragma unroll
                    for (int j = 0; j < 4; ++j) a[j] = g[j] * sigmoidf_(g[j]) * up[j];
                    u32x2 w; w.x = cvt_pk_bf16(a[0], a[1]); w.y = cvt_pk_bf16(a[2], a[3]);
                    *(u32x2*)(ACT + row * DEXP + col0 + bj * 64) = w; } }
    }
};
struct EpiDown {
    static constexpr bool PERM = true, AFTER_DRAIN = false;
    const int* SLOT_TK; const float* SLOT_W; bf16_t* CONTRIB;
    __device__ __forceinline__ void operator()(const f32x4 (&acc)[2][2][4][2], const Unit& u, int wr, int wc, int fr, int fq) const {
        const int row0 = u.pm * BM + wr * 64 + fr, col0 = u.pn * BM + wc * 32 + 8 * fq;
#pragma unroll
        for (int ai = 0; ai < 2; ++ai)
#pragma unroll
            for (int m = 0; m < 4; ++m) { const int row = row0 + ai * HALF + m * 16; const int tk = SLOT_TK[row]; const float w = SLOT_W[row];
                if (tk >= 0) {
#pragma unroll
                    for (int bj = 0; bj < 2; ++bj) *(u32x4*)(CONTRIB + (size_t)tk * DM + col0 + bj * HALF) = pack8(acc[ai][bj][m][0] * w, acc[ai][bj][m][1] * w); } }
    }
};

template <class Epi, class Sched, bool ALIGN_EPI = false, bool SP2 = false>
__device__ __forceinline__ void gemm_phase(PG8_LAS unsigned char* lds, const Gemm g, const Sched& S, const Epi& E, const int wave_sgpr) {
    int tid_ = wave_sgpr * 64 + lane_id_asm();
    const int tid = tid_, wid = __builtin_amdgcn_readfirstlane(tid >> 6), lane = tid & 63, wr = wid >> 2, wc = wid & 3, fr = lane & 15, fq = lane >> 4;
    int K_ = g.K; asm volatile("" : "+s"(K_));
    const int K = K_, nt = K / BK;
    unsigned voffA[2], voffB[2];
#pragma unroll
    for (int i = 0; i < 2; ++i) { int R, C; stage_rc(tid * 16 + i * 8192, R, C); const int Rb = Epi::PERM ? ((R & ~31) + perm32(R & 31)) : R;
        voffA[i] = (unsigned)(R * K + C) * 2u; voffB[i] = (unsigned)(Rb * K + C) * 2u; }
    const size_t kstep = (size_t)(BK * 2);
    const size_t hstep = (size_t)HALF * K * 2;
    const size_t tstep = 2 * hstep;
    const unsigned ldsw = (unsigned)wid * 1024u;
    const int aoff = lds_byte(wr * 64 + fr, fq * 8), boff = lds_byte(wc * 32 + fr, fq * 8);
#define PG8_SA(b, h) (((b) * 2 + (h)) * HTB)
#define PG8_SB(b, h) ((4 + (b) * 2 + (h)) * HTB)
#define PG8_STAGE(bufoff, gbase, voff) do { _Pragma("unroll") for (int _i = 0; _i < 2; ++_i) \
        __builtin_amdgcn_global_load_lds((const unsigned*)((const char*)(gbase) + (voff)[_i]), (PG8_LAS unsigned*)(lds + (bufoff) + ldsw + _i * 8192), 16, 0, 0); } while (0)
#define PG8_LDA(dst, b, h) do { _Pragma("unroll") for (int m = 0; m < 4; ++m) _Pragma("unroll") for (int k = 0; k < 2; ++k) dst[m][k] = *(const PG8_LAS bf16x8*)(lds + PG8_SA(b, h) + aoff + m * 2048 + k * 1024); } while (0)
#define PG8_LDB(dst, b, h) do { _Pragma("unroll") for (int n = 0; n < 2; ++n) _Pragma("unroll") for (int k = 0; k < 2; ++k) dst[n][k] = *(const PG8_LAS bf16x8*)(lds + PG8_SB(b, h) + boff + n * 2048 + k * 1024); } while (0)
#define PG8_MMA(ai, bj, At, Bt) do { __builtin_amdgcn_s_setprio(1); _Pragma("unroll") for (int m = 0; m < 4; ++m) _Pragma("unroll") for (int n = 0; n < 2; ++n) _Pragma("unroll") for (int k = 0; k < 2; ++k) \
        acc[ai][bj][m][n] = __builtin_amdgcn_mfma_f32_16x16x32_bf16(Bt[n][k], At[m][k], acc[ai][bj][m][n], 0, 0, 0); __builtin_amdgcn_s_setprio(0); } while (0)
#define PG8_WAIT_V(n) asm volatile("s_waitcnt vmcnt(" #n ")" ::: "memory")
#define PG8_WAIT_L(n) asm volatile("s_waitcnt lgkmcnt(" #n ")" ::: "memory")
#define PG8_BAR __builtin_amdgcn_s_barrier()
#define PG8_SCHED __builtin_amdgcn_sched_barrier(0)
    Unit cur, nxt; int ui = 0;
    if (!S.next(0, cur)) return;
    f32x4 acc[2][2][4][2];
#pragma unroll
    for (int a = 0; a < 2; ++a)
#pragma unroll
        for (int b = 0; b < 2; ++b)
#pragma unroll
            for (int m = 0; m < 4; ++m)
#pragma unroll
                for (int n = 0; n < 2; ++n) acc[a][b][m][n] = (f32x4){0.f, 0.f, 0.f, 0.f};
    bf16x8 At[4][2], B0[2][2], B1[2][2];
    const char* cA = (const char*)g.A + (size_t)cur.pm * tstep; const char* cB = (const char*)g.Bt + (size_t)cur.boff * 2 + (size_t)cur.pn * tstep;
    S.a_ready(cur);
    if constexpr (SP2) {
        PG8_STAGE(PG8_SB(0, 0), cB, voffB); PG8_STAGE(PG8_SB(0, 1), cB + hstep, voffB); PG8_STAGE(PG8_SA(0, 0), cA, voffA); PG8_STAGE(PG8_SA(0, 1), cA + hstep, voffA);
        if (wr == 1) PG8_BAR;
        PG8_WAIT_V(2); PG8_BAR;
        PG8_STAGE(PG8_SB(1, 0), cB + kstep, voffB); PG8_STAGE(PG8_SA(1, 0), cA + kstep, voffA); PG8_STAGE(PG8_SB(1, 1), cB + hstep + kstep, voffB);
        PG8_WAIT_V(6); PG8_BAR;
    } else {
        PG8_STAGE(PG8_SB(0, 0), cB, voffB); PG8_STAGE(PG8_SA(0, 0), cA, voffA); PG8_STAGE(PG8_SB(0, 1), cB + hstep, voffB); PG8_STAGE(PG8_SA(0, 1), cA + hstep, voffA);
        if (wr == 1) PG8_BAR;
        PG8_WAIT_V(4); PG8_BAR;
        PG8_STAGE(PG8_SB(1, 0), cB + kstep, voffB); PG8_STAGE(PG8_SA(1, 0), cA + kstep, voffA); PG8_STAGE(PG8_SB(1, 1), cB + hstep + kstep, voffB);
        PG8_WAIT_V(6); PG8_BAR;
    }
    for (;;) {
        const bool has_next = S.next(ui + 1, nxt);
        const char* nA = has_next ? (const char*)g.A + (size_t)nxt.pm * tstep : cA; const char* nB = has_next ? (const char*)g.Bt + (size_t)nxt.boff * 2 + (size_t)nxt.pn * tstep : cB;
        for (int t = 0; t < nt; t += 2) {
            const bool last = (t == nt - 2);
            const char* a1 = cA + (size_t)(t + 1) * kstep;
            const char* a2 = last ? nA : cA + (size_t)(t + 2) * kstep; const char* b2 = last ? nB : cB + (size_t)(t + 2) * kstep;
            const char* a3 = a2 + kstep; const char* b3 = b2 + kstep;
            if (last && has_next) S.a_ready(nxt);
            if constexpr (SP2) {
            PG8_LDB(B0, 0, 0); PG8_LDB(B1, 0, 1); PG8_SCHED; PG8_LDA(At, 0, 0); PG8_STAGE(PG8_SA(1, 1), a1 + hstep, voffA);
            PG8_WAIT_V(8); PG8_WAIT_L(0); PG8_BAR; PG8_MMA(0, 0, At, B0); PG8_MMA(0, 1, At, B1); PG8_BAR; PG8_SCHED;
            PG8_LDA(At, 0, 1); PG8_STAGE(PG8_SB(0, 0), b2, voffB); PG8_STAGE(PG8_SB(0, 1), b2 + hstep, voffB); PG8_STAGE(PG8_SA(0, 0), a2, voffA);
            PG8_WAIT_V(8); PG8_WAIT_L(0); PG8_BAR; PG8_MMA(1, 0, At, B0); PG8_MMA(1, 1, At, B1); PG8_BAR; PG8_SCHED;
            PG8_LDB(B0, 1, 0); PG8_LDB(B1, 1, 1); PG8_SCHED; PG8_LDA(At, 1, 0); PG8_STAGE(PG8_SA(0, 1), a2 + hstep, voffA);
            PG8_WAIT_V(8); PG8_WAIT_L(0); PG8_BAR; PG8_MMA(0, 0, At, B0); PG8_MMA(0, 1, At, B1); PG8_BAR; PG8_SCHED;
            PG8_LDA(At, 1, 1); PG8_STAGE(PG8_SB(1, 0), b3, voffB); PG8_STAGE(PG8_SB(1, 1), b3 + hstep, voffB); PG8_STAGE(PG8_SA(1, 0), a3, voffA);
            PG8_WAIT_V(8); PG8_WAIT_L(0); PG8_BAR; PG8_MMA(1, 0, At, B0); PG8_MMA(1, 1, At, B1); PG8_BAR; PG8_SCHED;
            } else {
            PG8_LDB(B0, 0, 0); PG8_SCHED; PG8_LDA(At, 0, 0); PG8_STAGE(PG8_SA(1, 1), a1 + hstep, voffA);
            PG8_WAIT_L(8); PG8_BAR; PG8_WAIT_L(0); PG8_MMA(0, 0, At, B0); PG8_BAR; PG8_SCHED;
            PG8_LDB(B1, 0, 1); PG8_STAGE(PG8_SB(0, 0), b2, voffB);
            PG8_BAR; PG8_WAIT_L(0); PG8_MMA(0, 1, At, B1); PG8_BAR;
            PG8_LDA(At, 0, 1); PG8_STAGE(PG8_SA(0, 0), a2, voffA);
            PG8_BAR; PG8_WAIT_L(0); PG8_MMA(1, 0, At, B0); PG8_BAR; PG8_SCHED;
            PG8_STAGE(PG8_SB(0, 1), b2 + hstep, voffB);
            PG8_WAIT_V(6); PG8_BAR; PG8_MMA(1, 1, At, B1); PG8_BAR;
            PG8_LDB(B0, 1, 0); PG8_SCHED; PG8_LDA(At, 1, 0); PG8_STAGE(PG8_SA(0, 1), a2 + hstep, voffA);
            PG8_WAIT_L(8); PG8_BAR; PG8_WAIT_L(0); PG8_MMA(0, 0, At, B0); PG8_BAR; PG8_SCHED;
            PG8_LDB(B1, 1, 1); PG8_STAGE(PG8_SB(1, 0), b3, voffB);
            PG8_BAR; PG8_WAIT_L(0); PG8_MMA(0, 1, At, B1); PG8_BAR;
            PG8_LDA(At, 1, 1); PG8_STAGE(PG8_SA(1, 0), a3, voffA);
            PG8_BAR; PG8_WAIT_L(0); PG8_MMA(1, 0, At, B0); PG8_BAR; PG8_SCHED;
            PG8_STAGE(PG8_SB(1, 1), b3 + hstep, voffB);
            PG8_WAIT_V(6); PG8_BAR; PG8_MMA(1, 1, At, B1); PG8_BAR;
            }
        }
        if constexpr (ALIGN_EPI) { if (wr == 0) PG8_BAR; }
        if constexpr (!Epi::AFTER_DRAIN) { E(acc, cur, wr, wc, fr, fq); S.done(cur); }
        if (!has_next) break;
#pragma unroll
        for (int a = 0; a < 2; ++a)
#pragma unroll
            for (int b = 0; b < 2; ++b)
#pragma unroll
                for (int m = 0; m < 4; ++m)
#pragma unroll
                    for (int n = 0; n < 2; ++n) acc[a][b][m][n] = (f32x4){0.f, 0.f, 0.f, 0.f};
        cur = nxt; cA = nA; cB = nB; ++ui;
        if constexpr (ALIGN_EPI) { if (wr == 1) PG8_BAR; }
    }
    PG8_WAIT_V(0);
    if constexpr (!ALIGN_EPI) { if (wr == 0) PG8_BAR; }
    PG8_BAR;
    if constexpr (Epi::AFTER_DRAIN) { E.fused(acc, cur, wr, wc, fr, fq, lds, wid, lane); S.done(cur); }
#undef PG8_SA
#undef PG8_SB
#undef PG8_STAGE
#undef PG8_LDA
#undef PG8_LDB
#undef PG8_MMA
#undef PG8_WAIT_V
#undef PG8_WAIT_L
#undef PG8_BAR
#undef PG8_SCHED
}
}

constexpr size_t MiB = 1u << 20;
constexpr size_t WS_CTL = 0, CTL_ZERO_BYTES = 1 * MiB;
constexpr size_t WS_MODP = 1 * MiB;
constexpr size_t WS_MOD = WS_MODP + 8 * 4 * 6144 * 4;
constexpr size_t WS_SMALL = 2 * MiB;
constexpr size_t WS_LIST_TK = WS_SMALL, WS_LIST_W = WS_SMALL + 2 * MiB;
constexpr size_t WS_WIN = 6 * MiB;
constexpr size_t WS_WFOLD = 16 * MiB, WS_WBA = 17 * MiB, WS_WOUT = 18 * MiB;
constexpr size_t WS_W1 = 20 * MiB;
constexpr size_t WS_W2 = 84 * MiB;
constexpr size_t WS_A = 116 * MiB;
constexpr size_t WS_G = WS_A;
constexpr size_t WS_QS = WS_A + 64 * MiB, WS_KS = WS_QS + 24 * MiB, WS_VS = WS_KS + 24 * MiB;
constexpr size_t WS_U = WS_A + 136 * MiB;
constexpr size_t WS_H = WS_A + 152 * MiB;
constexpr size_t WS_OG0 = WS_WIN;
constexpr size_t WS_LSE = WS_WIN + 8 * MiB;
constexpr size_t WS_OG12 = WS_H;
constexpr size_t WS_POOLED = WS_H + 16 * MiB;
constexpr size_t WS_TMP = WS_A + 64 * MiB;
constexpr size_t WS_OC = WS_A + 96 * MiB;
constexpr size_t WS_MERGED = WS_A + 104 * MiB;
constexpr size_t WS_Y = WS_A;
constexpr size_t WS_YSTAT = WS_A + 136 * MiB;
constexpr size_t WS_H2 = WS_A + 32 * MiB;
constexpr size_t WS_XS = WS_A + 64 * MiB;
constexpr size_t WS_SLOT_TK = WS_A + 144 * MiB, WS_SLOT_W = WS_A + 145 * MiB;
constexpr size_t WS_ACT = WS_A;
constexpr size_t WS_CONTRIB = WS_A + 64 * MiB;
constexpr size_t WS_END = WS_A + 184 * MiB;
constexpr int CW_ECOUNT = 64;
constexpr int CW_BAR = 4096;

constexpr int RING_BYTES = 131072;
constexpr int LDS_BYTES = 163840;
constexpr int MISC_OFF = LDS_BYTES - 512;
constexpr int SEG_OFF = LDS_BYTES - 1024;
constexpr int NWAVES = 8;

#define RLX_AGENT __ATOMIC_RELAXED, __HIP_MEMORY_SCOPE_AGENT
#define LDS_WAIT() asm volatile("s_waitcnt lgkmcnt(0)" ::: "memory")
#define VM_WAIT() asm volatile("s_waitcnt vmcnt(0)" ::: "memory")
typedef GAS unsigned gu32;
#define XB_TMO      128
#define XB_XCNT(j)  (256  + 64 * (j))
#define XB_XSUB(j)  (1280 + 64 * (j))
#define XB_XGEN(j)  (2304 + 64 * (j))
#define XB_TOP      3328
#define XB_TOPGEN   3392
#define XCD_BAR_WORDS 3456
#define XB_SPIN_CAP (1u << 18)

__device__ __forceinline__ unsigned xb_ld(unsigned* p)              { return __hip_atomic_load(p, __ATOMIC_RELAXED, __HIP_MEMORY_SCOPE_AGENT); }
__device__ __forceinline__ unsigned xb_add(unsigned* p, unsigned v) { return __hip_atomic_fetch_add(p, v, __ATOMIC_RELAXED, __HIP_MEMORY_SCOPE_AGENT); }
__device__ __forceinline__ unsigned xb_xcc_id() { return (unsigned)__builtin_amdgcn_s_getreg((3 << 11) | 20) & 0xFu; }
#define XB_SPIN(cond, bar) do { unsigned _sp = 0; while (cond) { __builtin_amdgcn_s_sleep(1); \
    if ((++_sp & 255u) == 0u) { if (xb_ld(&(bar)[XB_TMO])) break; if (_sp > XB_SPIN_CAP) { atomicAdd(&(bar)[XB_TMO], 1u); break; } } } } while (0)

struct XcdBarrier {
    unsigned* bar; unsigned x;
    volatile LAS unsigned* st;
};

__device__ __forceinline__ XcdBarrier xcd_barrier_post(unsigned* bar, volatile LAS unsigned* st, bool t0) {
    XcdBarrier b; b.bar = bar; b.x = xb_xcc_id(); b.st = st;
    if (t0) (void)xb_add(&bar[XB_XCNT(b.x)], 1u);
    return b;
}
__device__ __forceinline__ void xcd_barrier_complete(unsigned* bar, unsigned x, unsigned& nloc, unsigned& nx) {
    const unsigned G = gridDim.x * gridDim.y * gridDim.z;
    unsigned sum, cnt, mine, sp = 0u;
    for (;;) {
        sum = 0u; cnt = 0u; mine = 0u;
#pragma unroll
        for (unsigned j = 0; j < 16; ++j) { const unsigned c = xb_ld(&bar[XB_XCNT(j)]); sum += c; cnt += (c > 0u) ? 1u : 0u; mine = (j == x) ? c : mine; }
        if (sum == G) break;
        __builtin_amdgcn_s_sleep(1);
        if ((++sp & 255u) == 0u) { if (xb_ld(&bar[XB_TMO])) break; if (sp > XB_SPIN_CAP) { atomicAdd(&bar[XB_TMO], 1u); break; } }
    }
    nloc = mine > 0u ? mine : 1u; nx = cnt > 0u ? cnt : 1u;
}

__device__ __forceinline__ void xcd_barrier(const XcdBarrier& b, bool t0) {
    asm volatile("s_waitcnt vmcnt(0)" ::: "memory");
    __syncthreads();
    if (t0) {
        unsigned* bar = b.bar;
        __builtin_amdgcn_s_waitcnt(0);
        unsigned nloc = b.st[0], nx = b.st[1];
        if (nloc == 0u) { xcd_barrier_complete(bar, b.x, nloc, nx); b.st[0] = nloc; b.st[1] = nx; }
        const unsigned old = xb_add(&bar[XB_XSUB(b.x)], 1u);
        const unsigned gen = old / nloc;
        if (old + 1u == (gen + 1u) * nloc) {
            __builtin_amdgcn_fence(__ATOMIC_RELEASE, "agent");
            asm volatile("s_waitcnt vmcnt(0)" ::: "memory");
            const unsigned og = xb_add(&bar[XB_TOP], 1u);
            const unsigned tg = og / nx;
            if (og + 1u == (tg + 1u) * nx) xb_add(&bar[XB_TOPGEN], 1u);
            else XB_SPIN(xb_ld(&bar[XB_TOPGEN]) == tg, bar);
            __builtin_amdgcn_fence(__ATOMIC_ACQUIRE, "agent");
            xb_add(&bar[XB_XGEN(b.x)], 1u);
            asm volatile("s_waitcnt vmcnt(0)" ::: "memory");
        } else {
            XB_SPIN(xb_ld(&bar[XB_XGEN(b.x)]) == gen, bar);
            __builtin_amdgcn_fence(__ATOMIC_ACQUIRE, "agent");
            asm volatile("s_waitcnt vmcnt(0)" ::: "memory");
        }
    }
    __syncthreads();
}


struct Args {
    const float* x; const float* c; const float* w_ada; const float* b_ada;
    const float* g_pre_mix; const float* g_post_mix; const float* g_pre_ffn; const float* g_post_ffn;
    const float* w_in; const float* w_pool_group; const float* pool_scale; const float* w_branch_pool; const float* w_branch_att; const float* w_out;
    const float* w_group_router; const float* b_group_router; const float* w_expert_router; const float* b_expert_router;
    const float* w_exp_gate; const float* w_exp_up; const float* w_exp_down;
    float* out; unsigned char* ws;
};
struct Frame {
    LAS unsigned char* lds;
    int tid, lane, wave, G, vcu;
};

template <int MAP>
__device__ __forceinline__ void transpose_item(const float* W, int K, int N, bf16_t* WT, LAS float* scr, int item, int lane) {
    const int nblk = N / 32, kb = item / nblk, nb = item % nblk, k0 = 64 * kb, n0 = 32 * nb;
#pragma unroll 8
    for (int i = 0; i < 32; ++i) { const int kk = 2 * i + (lane >> 5); scr[kk * 33 + (lane & 31)] = W[(size_t)(k0 + kk) * N + n0 + (lane & 31)]; }
    LDS_WAIT(); asm volatile("" ::: "memory");
    const int c = lane & 7;
#pragma unroll
    for (int j = 0; j < 4; ++j) { const int n = (lane >> 3) + 8 * j; const LAS float* s = scr + (8 * c) * 33 + n;
        u32x4 o; o.x = pk2(s[0 * 33], s[1 * 33]); o.y = pk2(s[2 * 33], s[3 * 33]); o.z = pk2(s[4 * 33], s[5 * 33]); o.w = pk2(s[6 * 33], s[7 * 33]);
        const int ng = n0 + n; const int row = MAP == 0 ? ng : ((ng >> 2) * 8 + (ng & 3) + (MAP == 2 ? 4 : 0));
        *(GAS u32x4*)(WT + (size_t)row * K + k0 + 8 * c) = o; }
    LDS_WAIT(); asm volatile("" ::: "memory");
}

__device__ __forceinline__ void p0_gemv_item(const Frame& F, const Args& a, int item) {
    const int cc = item % 24, kg = item / 24;
    const int col = cc * 256 + 4 * F.lane, kbase = kg * 128 + F.wave * 16;
    f32x4 acc[4] = {{0.f, 0.f, 0.f, 0.f}, {0.f, 0.f, 0.f, 0.f}, {0.f, 0.f, 0.f, 0.f}, {0.f, 0.f, 0.f, 0.f}};
#pragma unroll 4
    for (int i = 0; i < 16; ++i) { const int k = kbase + i; const f32x4 w = *(const f32x4*)(a.w_ada + (size_t)k * 6144 + col);
#pragma unroll
        for (int b = 0; b < 4; ++b) { const float cv = a.c[b * DM + k]; const float s = cv * sigmoidf_(cv); acc[b] += w * s; } }
    LAS f32x4* red = (LAS f32x4*)F.lds;
#pragma unroll
    for (int b = 0; b < 4; ++b) red[(F.wave * 4 + b) * 64 + F.lane] = acc[b];
    __syncthreads();
    if (F.tid < 256) { const int b = F.tid >> 6, l = F.tid & 63; f32x4 s = red[b * 64 + l];
#pragma unroll
        for (int w = 1; w < 8; ++w) s += red[(w * 4 + b) * 64 + l];
        *(f32x4*)((float*)(a.ws + WS_MODP) + (size_t)(kg * 4 + b) * 6144 + cc * 256 + 4 * l) = s; }
    __syncthreads();
}
__device__ __forceinline__ void p0_fold_item(const Frame& F, const Args& a, int item) {
    const int g = item >> 4, d0 = (item & 15) * 64;
    LAS float* sWg = (LAS float*)F.lds;
    LAS float* sWb = sWg + 128 * 129;
    for (int i = F.tid; i < 128 * 128; i += 512) { const int c = i >> 7, j = i & 127; sWg[c * 129 + j] = a.w_pool_group[(size_t)g * 16384 + i]; }
    for (int i = F.tid; i < 128 * 64; i += 512) { const int j = i >> 6, d = i & 63; sWb[i] = a.pool_scale[g * 128 + j] * a.w_branch_pool[(size_t)(g * 128 + j) * DM + d0 + d]; }
    __syncthreads();
    const int d = F.tid & 63, cg0 = (F.tid >> 6) * 16;
    float acc[16];
#pragma unroll
    for (int i = 0; i < 16; ++i) acc[i] = 0.f;
    for (int j = 0; j < 128; ++j) { const float wb = sWb[j * 64 + d];
#pragma unroll
        for (int i = 0; i < 16; ++i) acc[i] += sWg[(cg0 + i) * 129 + j] * wb; }
    bf16_t* dst = (bf16_t*)(a.ws + WS_WFOLD) + (size_t)(d0 + d) * POOLW + g * 128 + cg0;
    u32x4 o0, o1;
    o0.x = pk2(acc[0], acc[1]); o0.y = pk2(acc[2], acc[3]); o0.z = pk2(acc[4], acc[5]); o0.w = pk2(acc[6], acc[7]);
    o1.x = pk2(acc[8], acc[9]); o1.y = pk2(acc[10], acc[11]); o1.z = pk2(acc[12], acc[13]); o1.w = pk2(acc[14], acc[15]);
    *(u32x4*)dst = o0; *(u32x4*)(dst + 8) = o1;
    __syncthreads();
}
__device__ __forceinline__ void p0_prologue(const Frame& F, const Args& a) {
    for (int it = F.vcu; it < 256; it += F.G) { if (it < 192) p0_gemv_item(F, a, it); else p0_fold_item(F, a, it - 192); }
    __syncthreads();
    LAS float* scr = (LAS float*)(F.lds + F.wave * 16384);
    const int gw = F.vcu * NWAVES + F.wave, NGW = F.G * NWAVES;
    constexpr int I_IN = (DM / 64) * (NIN / 32), I_BA = (256 / 64) * (DM / 32), I_OUT = (DM / 64) * (DM / 32);
    constexpr int I_GU = (DM / 64) * (DEXP / 32), I_DN = (DEXP / 64) * (DM / 32);
    constexpr int NITEMS = I_IN + I_BA + I_OUT + NEXP * (2 * I_GU + I_DN);
    for (int it = gw; it < NITEMS; it += NGW) {
        int r = it;
        if (r < I_IN) { transpose_item<0>(a.w_in, DM, NIN, (bf16_t*)(a.ws + WS_WIN), scr, r, F.lane); continue; } r -= I_IN;
        if (r < I_BA) { transpose_item<0>(a.w_branch_att, 256, DM, (bf16_t*)(a.ws + WS_WBA), scr, r, F.lane); continue; } r -= I_BA;
        if (r < I_OUT) { transpose_item<0>(a.w_out, DM, DM, (bf16_t*)(a.ws + WS_WOUT), scr, r, F.lane); continue; } r -= I_OUT;
        const int e = r / (2 * I_GU + I_DN); r -= e * (2 * I_GU + I_DN);
        bf16_t* w1 = (bf16_t*)(a.ws + WS_W1) + (size_t)e * DM * DM; bf16_t* w2 = (bf16_t*)(a.ws + WS_W2) + (size_t)e * DM * DEXP;
        if (r < I_GU) { transpose_item<1>(a.w_exp_gate + (size_t)e * DM * DEXP, DM, DEXP, w1, scr, r, F.lane); continue; } r -= I_GU;
        if (r < I_GU) { transpose_item<2>(a.w_exp_up + (size_t)e * DM * DEXP, DM, DEXP, w1, scr, r, F.lane); continue; } r -= I_GU;
        transpose_item<0>(a.w_exp_down + (size_t)e * DEXP * DM, DEXP, DM, w2, scr, r, F.lane);
    }
}

__device__ __forceinline__ float mod_value(const Args& a, int b, int n) {
    const float* mp = (const float*)(a.ws + WS_MODP) + (size_t)b * 6144 + n; float s = a.b_ada[n];
#pragma unroll
    for (int kg = 0; kg < 8; ++kg) s += mp[(size_t)kg * 4 * 6144];
    return s;
}
__device__ __forceinline__ void p1_adaln(const Frame& F, const Args& a) {
    LAS float* tA = (LAS float*)F.lds; LAS float* tC = tA + DM;
    float* mod = (float*)(a.ws + WS_MOD);
    for (int i = F.vcu * 512 + F.tid; i < 4 * 6144; i += F.G * 512) mod[i] = mod_value(a, i / 6144, i % 6144);
    for (int chunk = F.vcu; chunk < NT / 64; chunk += F.G) {
        const int r0 = chunk * 64, b = r0 / SEQ;
        __syncthreads();
        for (int col = F.tid; col < DM; col += 512) { tA[col] = a.g_pre_mix[col] * (1.0f + mod_value(a, b, DM + col)); tC[col] = mod_value(a, b, col); }
        __syncthreads();
        f32x4 ta[4], tc[4];
#pragma unroll
        for (int j = 0; j < 4; ++j) { ta[j] = *(const LAS f32x4*)(tA + 256 * j + 4 * F.lane); tc[j] = *(const LAS f32x4*)(tC + 256 * j + 4 * F.lane); }
        for (int r = r0 + F.wave; r < r0 + 64; r += NWAVES) {
            const f32x4* xr = (const f32x4*)(a.x + (size_t)r * DM) + F.lane; f32x4 v[4]; float s = 0.f;
#pragma unroll
            for (int j = 0; j < 4; ++j) { v[j] = xr[64 * j]; s += (v[j][0] * v[j][0] + v[j][1] * v[j][1]) + (v[j][2] * v[j][2] + v[j][3] * v[j][3]); }
            const float rstd = 1.0f / sqrtf(wave_sum(s) * (1.0f / DM) + RMS_EPS);
            u32x2* o8 = (u32x2*)((bf16_t*)(a.ws + WS_H) + (size_t)r * DM) + F.lane;
#pragma unroll
            for (int j = 0; j < 4; ++j) { const f32x4 h = v[j] * rstd * ta[j] + tc[j]; u32x2 w; w.x = pk2(h[0], h[1]); w.y = pk2(h[2], h[3]); o8[64 * j] = w; }
        }
    }
}

constexpr int ATT_KSTR = 128, ATT_VSTR = 192, ATT_ROWS = 384;
constexpr int ATT_K_OFF = 0, ATT_V_OFF = ATT_ROWS * ATT_KSTR;
typedef short v4i16_t __attribute__((ext_vector_type(4)));
__device__ __forceinline__ int crow(int r, int hi) { return (r & 3) + 8 * (r >> 2) + 4 * hi; }
__device__ __forceinline__ void attn_item(const Frame& F, const Args& a, int it) {
    const int grp = it >> 8, rem = it & 255, sh = 2 * grp, dil = 1 << sh, nqc = 16 >> sh, sublen = SEQ >> sh;
    const int qc = rem % nqc, r_ = (rem / nqc) % dil, bh = rem / (nqc * dil), hh = bh & 3, b = bh >> 2;
    const int head = grp * 4 + hh, q0 = qc * 256;
    const size_t headbase = ((size_t)(b * NHEAD + head) * SEQ + (size_t)r_ * sublen) * HD;
    const bf16_t* Qh = (const bf16_t*)(a.ws + WS_QS) + headbase;
    const bf16_t* Kh = (const bf16_t*)(a.ws + WS_KS) + headbase;
    const bf16_t* Vh = (const bf16_t*)(a.ws + WS_VS) + headbase;
    LAS unsigned char* sK = F.lds + ATT_K_OFF; LAS unsigned char* sV = F.lds + ATT_V_OFF;
    __syncthreads();
#pragma unroll
    for (int i = 0; i < 6; ++i) { const int idx = F.tid + i * 512, row = idx >> 3, ch = idx & 7; const int ks = q0 - 128 + row;
        u32x4 kv = {0u, 0u, 0u, 0u}, vv = {0u, 0u, 0u, 0u};
        if (ks >= 0) { kv = *(const u32x4*)(Kh + (size_t)ks * HD + ch * 8); vv = *(const u32x4*)(Vh + (size_t)ks * HD + ch * 8); }
        *(LAS u32x4*)(sK + row * ATT_KSTR + ((ch ^ (row & 7)) << 4)) = kv;
        *(LAS u32x4*)(sV + row * ATT_VSTR + (ch << 4)) = vv; }
    const int l = F.lane, l31 = l & 31, hi = l >> 5, w = F.wave;
    bf16x8 qf[4];
#pragma unroll
    for (int ds = 0; ds < 4; ++ds) qf[ds] = *(const bf16x8*)(Qh + (size_t)(q0 + 32 * w + l31) * HD + 16 * ds + 8 * hi);
    __syncthreads();
    const float slope2 = __builtin_amdgcn_exp2f(-8.0f * (float)(head + 1) / 12.0f) * LOG2E * (float)dil;
    const int kbase_sub = q0 - 128 + 32 * w;
    float mx = -INFINITY, lsum = 0.f;
    f32x16 o[2];
    o[0] = (f32x16){0.f, 0.f, 0.f, 0.f, 0.f, 0.f, 0.f, 0.f, 0.f, 0.f, 0.f, 0.f, 0.f, 0.f, 0.f, 0.f}; o[1] = o[0];
    const int g16 = l >> 4, q4 = (l & 15) >> 2, p4 = l & 3;
    const LAS unsigned char* vlane = sV + (32 * w + 4 * (g16 >> 1) + q4) * ATT_VSTR + (16 * (g16 & 1) + 4 * p4) * 2;
#pragma unroll
    for (int jj = 0; jj < 5; ++jj) { const int j = 4 - jj;
        f32x16 st = {0.f, 0.f, 0.f, 0.f, 0.f, 0.f, 0.f, 0.f, 0.f, 0.f, 0.f, 0.f, 0.f, 0.f, 0.f, 0.f};
        const int row = 32 * w + 32 * j + l31;
#pragma unroll
        for (int ds = 0; ds < 4; ++ds) { const bf16x8 kf = *(const LAS bf16x8*)(sK + row * ATT_KSTR + (((2 * ds + hi) ^ (row & 7)) << 4));
            st = __builtin_amdgcn_mfma_f32_32x32x16_bf16(kf, qf[ds], st, 0, 0, 0); }
        float tmax = -INFINITY;
#pragma unroll
        for (int r = 0; r < 16; ++r) { const int kk = 32 * j + crow(r, hi); const int delta = 128 + l31 - kk;
            const bool valid = (delta >= 0) && (delta <= 128) && (kbase_sub + kk >= 0);
            const float sv = valid ? st[r] - slope2 * (float)delta : -INFINITY; st[r] = sv; tmax = fmaxf(tmax, sv); }
        tmax = max_xor32(tmax);
        const float mnew = fmaxf(mx, tmax);
        const float alpha = __builtin_amdgcn_exp2f(mx - mnew);
        mx = mnew; lsum *= alpha;
#pragma unroll
        for (int r = 0; r < 16; ++r) { o[0][r] *= alpha; o[1][r] *= alpha; }
        float psum = 0.f;
#pragma unroll
        for (int r = 0; r < 16; ++r) { const float p = __builtin_amdgcn_exp2f(st[r] - mx); st[r] = p; psum += p; }
        lsum += psum;
#pragma unroll
        for (int s2 = 0; s2 < 2; ++s2) {
            u32x4 pw; pw.x = pk2(st[8 * s2 + 0], st[8 * s2 + 1]); pw.y = pk2(st[8 * s2 + 2], st[8 * s2 + 3]);
            pw.z = pk2(st[8 * s2 + 4], st[8 * s2 + 5]); pw.w = pk2(st[8 * s2 + 6], st[8 * s2 + 7]);
            const bf16x8 pb = __builtin_bit_cast(bf16x8, pw);
#pragma unroll
            for (int dt = 0; dt < 2; ++dt) {
                const LAS unsigned char* vp = vlane + (32 * j + 16 * s2) * ATT_VSTR + dt * 64;
                const s16x4 v0 = __builtin_bit_cast(s16x4, __builtin_amdgcn_ds_read_tr16_b64_v4i16((LAS v4i16_t*)vp));
                const s16x4 v1 = __builtin_bit_cast(s16x4, __builtin_amdgcn_ds_read_tr16_b64_v4i16((LAS v4i16_t*)(vp + 8 * ATT_VSTR)));
                const bf16x8 va = {v0[0], v0[1], v0[2], v0[3], v1[0], v1[1], v1[2], v1[3]};
                o[dt] = __builtin_amdgcn_mfma_f32_32x32x16_bf16(va, pb, o[dt], 0, 0, 0);
            }
        }
    }
    lsum = sum_xor32(lsum);
    const float rl = 1.0f / lsum;
    const int qsub = q0 + 32 * w + l31; const int tok = b * SEQ + qsub * dil + r_;
    bf16_t* og = (grp == 0 ? (bf16_t*)(a.ws + WS_OG0) : (bf16_t*)(a.ws + WS_OG12) + (size_t)(grp - 1) * NT * 256) + (size_t)tok * 256 + hh * 64;
#pragma unroll
    for (int dt = 0; dt < 2; ++dt)
#pragma unroll
        for (int rq = 0; rq < 4; ++rq) { u32x2 wv; wv.x = pk2(o[dt][4 * rq + 0] * rl, o[dt][4 * rq + 1] * rl); wv.y = pk2(o[dt][4 * rq + 2] * rl, o[dt][4 * rq + 3] * rl);
            *(u32x2*)(og + 32 * dt + 8 * rq + 4 * hi) = wv; }
    if (hi == 0) ((float*)(a.ws + WS_LSE))[((size_t)grp * NT + tok) * 4 + hh] = mx + __builtin_amdgcn_logf(lsum);
}
__device__ __forceinline__ void pool_item(const Frame& F, const Args& a, int it) {
    const int t0 = it * 64; const int tl0 = t0 % SEQ;
    const bf16_t* U = (const bf16_t*)(a.ws + WS_U);
    LAS unsigned* su = (LAS unsigned*)F.lds;
    __syncthreads();
    for (int i = F.tid; i < 79 * 256; i += 512) { const int row = i >> 8, cp = i & 255; const int tl = tl0 - 15 + row;
        su[i] = tl >= 0 ? *(const unsigned*)(U + (size_t)(t0 - 15 + row) * POOLW + 2 * cp) : 0u; }
    __syncthreads();
    const int cp = F.tid & 255, half = F.tid >> 8; const int g = cp >> 6; const int wdw = 2 << g;
    float s0 = 0.f, s1 = 0.f;
    const int tb = 32 * half;
    for (int i = 1; i < wdw; ++i) { const unsigned v = su[(15 + tb - i) * 256 + cp]; s0 += bf_lo(v); s1 += bf_hi(v); }
    bf16_t* P = (bf16_t*)(a.ws + WS_POOLED);
    for (int t = tb; t < tb + 32; ++t) {
        const unsigned v = su[(15 + t) * 256 + cp]; const float u0 = bf_lo(v), u1 = bf_hi(v);
        s0 += u0; s1 += u1;
        const int tl = tl0 + t; const float inv = 1.0f / (float)(tl + 1 < wdw ? tl + 1 : wdw);
        *(unsigned*)(P + (size_t)(t0 + t) * POOLW + 2 * cp) = pk2(s0 * inv - u0, s1 * inv - u1);
        const unsigned vo = su[(15 + t - wdw + 1) * 256 + cp]; s0 -= bf_lo(vo); s1 -= bf_hi(vo);
    }
}
__device__ __forceinline__ void combine_rows(const Frame& F, const Args& a) {
    const int gw = F.vcu * NWAVES + F.wave, NGW = F.G * NWAVES;
    const float* LSE = (const float*)(a.ws + WS_LSE);
    const bf16_t* og0 = (const bf16_t*)(a.ws + WS_OG0); const bf16_t* og1 = (const bf16_t*)(a.ws + WS_OG12); const bf16_t* og2 = og1 + (size_t)NT * 256;
    bf16_t* OC = (bf16_t*)(a.ws + WS_OC);
    for (int r = gw; r < NT; r += NGW) {
        const int hh = F.lane >> 4;
        const float l0 = LSE[(size_t)r * 4 + hh], l1 = LSE[((size_t)NT + r) * 4 + hh], l2 = LSE[((size_t)2 * NT + r) * 4 + hh];
        const float m = fmaxf(l0, fmaxf(l1, l2));
        float w0 = __builtin_amdgcn_exp2f(l0 - m), w1 = __builtin_amdgcn_exp2f(l1 - m), w2 = __builtin_amdgcn_exp2f(l2 - m);
        const float inv = 1.0f / (w0 + w1 + w2); w0 *= inv; w1 *= inv; w2 *= inv;
        const u32x2 a0 = *(const u32x2*)(og0 + (size_t)r * 256 + 4 * F.lane), a1 = *(const u32x2*)(og1 + (size_t)r * 256 + 4 * F.lane), a2 = *(const u32x2*)(og2 + (size_t)r * 256 + 4 * F.lane);
        u32x2 o;
        o.x = pk2(w0 * bf_lo(a0.x) + w1 * bf_lo(a1.x) + w2 * bf_lo(a2.x), w0 * bf_hi(a0.x) + w1 * bf_hi(a1.x) + w2 * bf_hi(a2.x));
        o.y = pk2(w0 * bf_lo(a0.y) + w1 * bf_lo(a1.y) + w2 * bf_lo(a2.y), w0 * bf_hi(a0.y) + w1 * bf_hi(a1.y) + w2 * bf_hi(a2.y));
        *(u32x2*)(OC + (size_t)r * 256 + 4 * F.lane) = o;
    }
}

constexpr int WR_STRIDE = 1028;
constexpr int P7_WR_OFF = 0, P7_TAB_OFF = 36 * WR_STRIDE * 4;
constexpr int P7_ASG_OFF = P7_TAB_OFF + 3 * DM * 4;
constexpr int P7_HIST_OFF = P7_ASG_OFF + 64 * 24;
static_assert(P7_HIST_OFF + 256 <= SEG_OFF, "P7 LDS map");
__device__ __forceinline__ void p7_router(const Frame& F, const Args& a) {
    LAS float* sW = (LAS float*)(F.lds + P7_WR_OFF);
    LAS float* tA1 = (LAS float*)(F.lds + P7_TAB_OFF); LAS float* tA2 = tA1 + DM; LAS float* tC2 = tA2 + DM;
    LAS int* asg = (LAS int*)(F.lds + P7_ASG_OFF); LAS int* hist = (LAS int*)(F.lds + P7_HIST_OFF); LAS int* hbase = hist + 32;
    const float* mod = (const float*)(a.ws + WS_MOD);
    __syncthreads();
    for (int i = F.tid; i < DM * 4; i += 512) { const int k = i >> 2, j = i & 3; sW[j * WR_STRIDE + k] = a.w_group_router[i]; }
    for (int i = F.tid; i < DM * 32; i += 512) { const int k = i >> 5, j = i & 31; sW[(4 + j) * WR_STRIDE + k] = a.w_expert_router[i]; }
    const bf16_t* Y = (const bf16_t*)(a.ws + WS_Y); const float* YSTAT = (const float*)(a.ws + WS_YSTAT);
    bf16_t* H2 = (bf16_t*)(a.ws + WS_H2);
    int* gcount = (int*)(a.ws + WS_CTL) + CW_ECOUNT;
    int* LIST_TK = (int*)(a.ws + WS_LIST_TK); float* LIST_W = (float*)(a.ws + WS_LIST_W);
    for (int chunk = F.vcu; chunk < NT / 64; chunk += F.G) {
        const int r0 = chunk * 64, b = r0 / SEQ;
        __syncthreads();
        for (int col = F.tid; col < DM; col += 512) {
            tA1[col] = mod[b * 6144 + 2 * DM + col] * a.g_post_mix[col];
            tA2[col] = a.g_pre_ffn[col] * (1.0f + mod[b * 6144 + 4 * DM + col]);
            tC2[col] = mod[b * 6144 + 3 * DM + col]; }
        if (F.tid < 32) hist[F.tid] = 0;
        __syncthreads();
        for (int rl = F.wave; rl < 64; rl += NWAVES) {
            const int r = r0 + rl;
            float ys = 0.f;
            if (F.lane < 16) ys = YSTAT[(size_t)r * 16 + F.lane];
            ys = wave_sum(ys);
            const float rstd_y = 1.0f / sqrtf(ys * (1.0f / DM) + RMS_EPS);
            const u32x2* yr = (const u32x2*)(Y + (size_t)r * DM) + F.lane; const f32x4* xr = (const f32x4*)(a.x + (size_t)r * DM) + F.lane;
            f32x4 x1[4]; float s1 = 0.f;
#pragma unroll
            for (int j = 0; j < 4; ++j) { const u32x2 yw = yr[64 * j]; const f32x4 xv = xr[64 * j]; const f32x4 t1 = *(const LAS f32x4*)(tA1 + 256 * j + 4 * F.lane);
                f32x4 yv = {bf_lo(yw.x), bf_hi(yw.x), bf_lo(yw.y), bf_hi(yw.y)};
                x1[j] = xv + t1 * yv * rstd_y;
                s1 += (x1[j][0] * x1[j][0] + x1[j][1] * x1[j][1]) + (x1[j][2] * x1[j][2] + x1[j][3] * x1[j][3]); }
            f32x4* xo = (f32x4*)(a.out + (size_t)r * DM) + F.lane;
#pragma unroll
            for (int j = 0; j < 4; ++j) xo[64 * j] = x1[j];
            const float rstd1 = 1.0f / sqrtf(wave_sum(s1) * (1.0f / DM) + RMS_EPS);
            f32x4 h2[4];
            u32x2* ho = (u32x2*)(H2 + (size_t)r * DM) + F.lane;
#pragma unroll
            for (int j = 0; j < 4; ++j) { const f32x4 t2 = *(const LAS f32x4*)(tA2 + 256 * j + 4 * F.lane), c2 = *(const LAS f32x4*)(tC2 + 256 * j + 4 * F.lane);
                h2[j] = x1[j] * rstd1 * t2 + c2; u32x2 w; w.x = pk2(h2[j][0], h2[j][1]); w.y = pk2(h2[j][2], h2[j][3]); ho[64 * j] = w; }
            float lg[36];
#pragma unroll
            for (int c = 0; c < 36; ++c) { float p = 0.f;
#pragma unroll
                for (int j = 0; j < 4; ++j) { const f32x4 wv = *(const LAS f32x4*)(sW + c * WR_STRIDE + 256 * j + 4 * F.lane);
                    p += (h2[j][0] * wv[0] + h2[j][1] * wv[1]) + (h2[j][2] * wv[2] + h2[j][3] * wv[3]); }
                lg[c] = wave_sum(p); }
            float gl[4];
#pragma unroll
            for (int j = 0; j < 4; ++j) gl[j] = lg[j] + a.b_group_router[j];
            int gs = 0; float gm = gl[0];
#pragma unroll
            for (int j = 1; j < 4; ++j) if (gl[j] > gm) { gm = gl[j]; gs = j; }
            float gden = 0.f;
#pragma unroll
            for (int j = 0; j < 4; ++j) gden += __expf(gl[j] - gm);
            const float pg = 1.0f / gden;
            float el[8];
#pragma unroll
            for (int j = 0; j < 8; ++j) { float v = 0.f;
#pragma unroll
                for (int g = 0; g < 4; ++g) v = (gs == g) ? lg[4 + g * 8 + j] + a.b_expert_router[g * 8 + j] : v;
                el[j] = v; }
            int i0 = 0; float v0 = el[0];
#pragma unroll
            for (int j = 1; j < 8; ++j) if (el[j] > v0) { v0 = el[j]; i0 = j; }
            int i1 = -1; float v1 = -INFINITY;
#pragma unroll
            for (int j = 0; j < 8; ++j) if (j != i0 && el[j] > v1) { v1 = el[j]; i1 = j; }
            const float e1 = __expf(v1 - v0); const float w0 = pg / (1.0f + e1), w1 = pg * e1 / (1.0f + e1);
            if (F.lane == 0) { const int ex0 = gs * 8 + i0, ex1 = gs * 8 + i1;
                const int k0 = atomicAdd((int*)&hist[ex0], 1), k1 = atomicAdd((int*)&hist[ex1], 1);
                asg[rl * 6 + 0] = ex0; asg[rl * 6 + 1] = ex1; asg[rl * 6 + 2] = k0; asg[rl * 6 + 3] = k1;
                ((LAS float*)asg)[rl * 6 + 4] = w0; ((LAS float*)asg)[rl * 6 + 5] = w1; }
        }
        __syncthreads();
        if (F.tid < 32) hbase[F.tid] = hist[F.tid] ? (int)__hip_atomic_fetch_add(gcount + F.tid, hist[F.tid], RLX_AGENT) : 0;
        __syncthreads();
        if (F.tid < 128) { const int rl = F.tid >> 1, k = F.tid & 1; const int e = asg[rl * 6 + k]; const int pos = hbase[e] + asg[rl * 6 + 2 + k];
            LIST_TK[e * NT + pos] = (r0 + rl) * 2 + k; LIST_W[e * NT + pos] = ((LAS float*)asg)[rl * 6 + 4 + k]; }
    }
}
__device__ __forceinline__ void moe_segments(const Frame& F, const Args& a) {
    LAS int* seg = (LAS int*)(F.lds + SEG_OFF); LAS int* cnt = seg + 40;
    const int* gcount = (const int*)(a.ws + WS_CTL) + CW_ECOUNT;
    __syncthreads();
    if (F.tid < 32) cnt[F.tid] = __hip_atomic_load(gcount + F.tid, RLX_AGENT);
    __syncthreads();
    if (F.tid == 0) { int s = 0; for (int e = 0; e < 32; ++e) { seg[e] = s; s += (cnt[e] + 255) >> 8; } seg[32] = s; }
    __syncthreads();
}
__device__ __forceinline__ int seg_find(const LAS int* seg, int tile) { int e = 0;
#pragma unroll
    for (int s = 16; s >= 1; s >>= 1) if (seg[e + s] <= tile) e += s;
    return e; }
__device__ __forceinline__ int seg_find_uniform(const LAS int* seg, int tile) { int e = 0;
#pragma unroll
    for (int s = 16; s >= 1; s >>= 1) if (__builtin_amdgcn_readfirstlane(seg[e + s]) <= tile) e += s;
    return e; }
__device__ __forceinline__ void p7b_gather(const Frame& F, const Args& a) {
    const LAS int* seg = (const LAS int*)(F.lds + SEG_OFF); const LAS int* cnt = seg + 40;
    const int total = seg[32] * 256;
    const int gw = F.vcu * NWAVES + F.wave, NGW = F.G * NWAVES;
    const int* LIST_TK = (const int*)(a.ws + WS_LIST_TK); const float* LIST_W = (const float*)(a.ws + WS_LIST_W);
    int* STK = (int*)(a.ws + WS_SLOT_TK); float* SW = (float*)(a.ws + WS_SLOT_W);
    const bf16_t* H2 = (const bf16_t*)(a.ws + WS_H2); bf16_t* XS = (bf16_t*)(a.ws + WS_XS);
    for (int R = gw; R < total; R += NGW) {
        const int e = seg_find(seg, R >> 8); const int i = R - seg[e] * 256;
        if (i < cnt[e]) { const int tk = LIST_TK[e * NT + i]; const float w = LIST_W[e * NT + i];
            const u32x4* src = (const u32x4*)(H2 + (size_t)(tk >> 1) * DM) + F.lane; u32x4* dst = (u32x4*)(XS + (size_t)R * DM) + F.lane;
            const u32x4 v0 = src[0], v1 = src[64]; dst[0] = v0; dst[64] = v1;
            if (F.lane == 0) { STK[R] = tk; SW[R] = w; } }
        else if (F.lane == 0) { STK[R] = -1; SW[R] = 0.f; }
    }
}
struct MoeOrder {
    const LAS int* seg; int G, c; long estride;
    __device__ __forceinline__ bool next(int i, pg8::Unit& u) const {
        const long L = (long)i * G + c; if (L >= (long)__builtin_amdgcn_readfirstlane(seg[32]) * 4) return false;
        u.pm = (int)(L >> 2); u.pn = (int)(L & 3); u.boff = (long)seg_find_uniform(seg, u.pm) * estride; return true; }
    __device__ __forceinline__ void a_ready(const pg8::Unit&) const {}
    __device__ __forceinline__ void done(const pg8::Unit&) const {}
};
__device__ __forceinline__ void p10_final(const Frame& F, const Args& a) {
    LAS float* tA = (LAS float*)F.lds;
    const float* mod = (const float*)(a.ws + WS_MOD);
    const bf16_t* C = (const bf16_t*)(a.ws + WS_CONTRIB);
    for (int chunk = F.vcu; chunk < NT / 64; chunk += F.G) {
        const int r0 = chunk * 64, b = r0 / SEQ;
        __syncthreads();
        for (int col = F.tid; col < DM; col += 512) tA[col] = mod[b * 6144 + 5 * DM + col] * a.g_post_ffn[col];
        __syncthreads();
        for (int r = r0 + F.wave; r < r0 + 64; r += NWAVES) {
            const u32x2* c0 = (const u32x2*)(C + (size_t)(2 * r) * DM) + F.lane; const u32x2* c1 = (const u32x2*)(C + (size_t)(2 * r + 1) * DM) + F.lane;
            f32x4* xo = (f32x4*)(a.out + (size_t)r * DM) + F.lane;
            f32x4 y[4], xv[4]; float s = 0.f;
#pragma unroll
            for (int j = 0; j < 4; ++j) { const u32x2 p = c0[64 * j], q = c1[64 * j]; xv[j] = xo[64 * j];
                y[j] = (f32x4){bf_lo(p.x) + bf_lo(q.x), bf_hi(p.x) + bf_hi(q.x), bf_lo(p.y) + bf_lo(q.y), bf_hi(p.y) + bf_hi(q.y)};
                s += (y[j][0] * y[j][0] + y[j][1] * y[j][1]) + (y[j][2] * y[j][2] + y[j][3] * y[j][3]); }
            const float rstd = 1.0f / sqrtf(wave_sum(s) * (1.0f / DM) + RMS_EPS);
#pragma unroll
            for (int j = 0; j < 4; ++j) { const f32x4 t = *(const LAS f32x4*)(tA + 256 * j + 4 * F.lane); xo[64 * j] = xv[j] + t * y[j] * rstd; }
        }
    }
}

__global__ void __launch_bounds__(NWAVES * 64, 2) fwd_megakernel(Args args) {
    extern __shared__ __attribute__((aligned(16))) unsigned char lds_raw[];
    Frame F; const Args* ap;
#define FRAME() do { ap = (const Args*)__builtin_amdgcn_kernarg_segment_ptr(); asm volatile("" : "+s"(ap)); \
        int t_ = wave_s * 64 + lane_id_asm(); \
        F.lds = (LAS unsigned char*)lds_raw; F.tid = t_; F.lane = t_ & 63; F.wave = wave_s; \
        F.G = gridDim.x; { const int bx = blockIdx.x; F.vcu = (F.G % 8 == 0) ? (bx % 8) * (F.G / 8) + bx / 8 : bx; } } while (0)
    const int wave_s = __builtin_amdgcn_readfirstlane((int)threadIdx.x >> 6);
    cg::this_grid().sync();
    FRAME();
    volatile LAS unsigned* MISC = (volatile LAS unsigned*)(F.lds + MISC_OFF);
    for (int u = F.tid; u < 128; u += NWAVES * 64) MISC[u] = 0u;
    __syncthreads();
    (void)xcd_barrier_post((unsigned*)(ap->ws + WS_CTL) + CW_BAR, MISC + 8, F.tid == 0);
#define GRID_BAR() do { FRAME(); XcdBarrier bar_; bar_.bar = (unsigned*)(ap->ws + WS_CTL) + CW_BAR; bar_.x = xb_xcc_id(); bar_.st = (volatile LAS unsigned*)(F.lds + MISC_OFF) + 8; xcd_barrier(bar_, F.tid == 0); } while (0)
#define a (*ap)
    LAS unsigned char* ring = F.lds;

#ifndef PHASE_MASK
#define PHASE_MASK 0xFFFF
#endif
#define PH(k) if constexpr ((PHASE_MASK >> (k)) & 1)
    FRAME();
    PH(0) p0_prologue(F, a);
    GRID_BAR();
    FRAME();
    PH(1) p1_adaln(F, a);
    GRID_BAR();
    FRAME();
    PH(2) {   pg8::Gemm g{(const bf16_t*)(a.ws + WS_H), (const bf16_t*)(a.ws + WS_WIN), NT, NIN, DM}; pg8::StaticOrder S; S.init(NT, NIN, F.G, (int)blockIdx.x);
        pg8::EpiProj E{(bf16_t*)(a.ws + WS_U), (bf16_t*)(a.ws + WS_QS), (bf16_t*)(a.ws + WS_G), 0.125f * LOG2E};
        pg8::gemm_phase<pg8::EpiProj, pg8::StaticOrder, true, true>(ring, g, S, E, wave_s); }
    GRID_BAR();
    FRAME();
    PH(3) for (int it = F.vcu; it < 768; it += F.G) attn_item(F, a, it);
    FRAME();
    PH(11) for (int it = F.vcu; it < NT / 64; it += F.G) pool_item(F, a, it);
    GRID_BAR();
    FRAME();
    PH(12) combine_rows(F, a);
    __syncthreads();
    FRAME();
    PH(4) {   pg8::Gemm g{(const bf16_t*)(a.ws + WS_POOLED), (const bf16_t*)(a.ws + WS_WFOLD), NT, DM, POOLW}; pg8::StaticOrder S; S.init(NT, DM, F.G, (int)blockIdx.x);
        pg8::EpiGate1 E{(const bf16_t*)(a.ws + WS_G), (bf16_t*)(a.ws + WS_TMP)};
        pg8::gemm_phase<pg8::EpiGate1, pg8::StaticOrder, true, true>(ring, g, S, E, wave_s); }
    GRID_BAR();
    FRAME();
    PH(5) {   pg8::Gemm g{(const bf16_t*)(a.ws + WS_OC), (const bf16_t*)(a.ws + WS_WBA), NT, DM, 256}; pg8::StaticOrder S; S.init(NT, DM, F.G, (int)blockIdx.x);
        pg8::EpiGate2 E{(const bf16_t*)(a.ws + WS_G), (const bf16_t*)(a.ws + WS_TMP), (bf16_t*)(a.ws + WS_MERGED)};
        pg8::gemm_phase<pg8::EpiGate2, pg8::StaticOrder, true, true>(ring, g, S, E, wave_s); }
    GRID_BAR();
    FRAME();
    PH(6) {   pg8::Gemm g{(const bf16_t*)(a.ws + WS_MERGED), (const bf16_t*)(a.ws + WS_WOUT), NT, DM, DM}; pg8::StaticOrder S; S.init(NT, DM, F.G, (int)blockIdx.x);
        pg8::EpiY E{(bf16_t*)(a.ws + WS_Y), (float*)(a.ws + WS_YSTAT)};
        pg8::gemm_phase<pg8::EpiY, pg8::StaticOrder, true, true>(ring, g, S, E, wave_s); }
    GRID_BAR();
    FRAME();
    PH(7) p7_router(F, a);
    GRID_BAR();
    FRAME();
    PH(13) { moe_segments(F, a);
    p7b_gather(F, a); }
    GRID_BAR();
    FRAME();
    PH(8) {   pg8::Gemm g{(const bf16_t*)(a.ws + WS_XS), (const bf16_t*)(a.ws + WS_W1), XS_ROWS, DM, DM};
        MoeOrder S{(const LAS int*)(F.lds + SEG_OFF), F.G, (int)blockIdx.x, (long)DM * DM};
        pg8::EpiAct E{(bf16_t*)(a.ws + WS_ACT)};
        pg8::gemm_phase<pg8::EpiAct, MoeOrder, true, true>(ring, g, S, E, wave_s); }
    GRID_BAR();
    FRAME();
    PH(9) {   pg8::Gemm g{(const bf16_t*)(a.ws + WS_ACT), (const bf16_t*)(a.ws + WS_W2), XS_ROWS, DM, DEXP};
        MoeOrder S{(const LAS int*)(F.lds + SEG_OFF), F.G, (int)blockIdx.x, (long)DM * DEXP};
        pg8::EpiDown E{(const int*)(a.ws + WS_SLOT_TK), (const float*)(a.ws + WS_SLOT_W), (bf16_t*)(a.ws + WS_CONTRIB)};
        pg8::gemm_phase<pg8::EpiDown, MoeOrder, true, true>(ring, g, S, E, wave_s); }
    GRID_BAR();
    FRAME();
    if constexpr (DIAG != 1 && DIAG != 2) p10_final(F, a);
#undef a
}

extern "C" void kernel_launch(void* const* d_in, const int* in_sizes, int n_in, void* d_out, int out_size, void* d_ws, size_t ws_size, hipStream_t stream) {
    static int grid = 0;
    if (grid == 0) {
        if (n_in != 21 || in_sizes[0] != NT * DM || out_size != NT * DM || ws_size < WS_END) {
            fprintf(stderr, "kernel_launch: unexpected shapes: n_in %d in0 %d out %d ws %zu (need %zu)\n", n_in, n_in > 0 ? in_sizes[0] : -1, out_size, ws_size, (size_t)WS_END); grid = -1; return; }
        int dev = 0, cus = 0, per_cu = 0;
        hipGetDevice(&dev);
        hipDeviceGetAttribute(&cus, hipDeviceAttributeMultiprocessorCount, dev);
        if (hipFuncSetAttribute((const void*)fwd_megakernel, hipFuncAttributeMaxDynamicSharedMemorySize, LDS_BYTES) != hipSuccess) { fprintf(stderr, "kernel_launch: hipFuncSetAttribute(%d) failed\n", LDS_BYTES); (void)hipGetLastError(); }
        if (hipOccupancyMaxActiveBlocksPerMultiprocessor(&per_cu, (const void*)fwd_megakernel, NWAVES * 64, LDS_BYTES) != hipSuccess || per_cu < 1) {
            fprintf(stderr, "kernel_launch: occupancy query says %d blocks per CU\n", per_cu); (void)hipGetLastError(); per_cu = 1; }
        grid = cus;
        if (grid > 256) grid = 256;
        fprintf(stderr, "kernel_launch: cus %d per_cu %d grid %d\n", cus, per_cu, grid);
    }
    if (grid < 0) return;
    hipMemsetAsync((char*)d_ws + WS_CTL, 0, CTL_ZERO_BYTES, stream);
    Args a{};
    const float** p = (const float**)&a;
    for (int i = 0; i < 21; ++i) p[i] = (const float*)d_in[i];
    a.out = (float*)d_out; a.ws = (unsigned char*)d_ws;
    void* kargs[] = {&a};
    hipError_t e = hipLaunchCooperativeKernel((const void*)fwd_megakernel, dim3(grid), dim3(NWAVES * 64), kargs, LDS_BYTES, stream);
    if (e != hipSuccess) fprintf(stderr, "kernel_launch: cooperative launch failed: %s (grid %d)\n", hipGetErrorString(e), grid);
}
```

```cpp
#include <hip/hip_runtime.h>
#include <hip/hip_cooperative_groups.h>
#include <cstdio>
#include <cstdint>
namespace cg = cooperative_groups;

#define LAS __attribute__((address_space(3)))
#define GAS __attribute__((address_space(1)))
typedef unsigned short bf16_t;
typedef short bf16x8 __attribute__((ext_vector_type(8)));
typedef short s16x4 __attribute__((ext_vector_type(4)));
typedef float f32x4 __attribute__((ext_vector_type(4)));
typedef float f32x16 __attribute__((ext_vector_type(16)));
typedef float f32x2 __attribute__((ext_vector_type(2)));
typedef unsigned u32x4 __attribute__((ext_vector_type(4)));
typedef unsigned u32x2 __attribute__((ext_vector_type(2)));

constexpr int NB = 4, SEQ = 4096, DM = 1024, NT = NB * SEQ;
constexpr int POOLW = 512, ATTW = 768, NIN = 4864, NHEAD = 12, HD = 64;
constexpr int NEXP = 32, DEXP = 512;
constexpr float RMS_EPS = 1e-6f;
constexpr float LOG2E = 1.4426950408889634f;
constexpr int XS_ROWS = 40960;

__device__ __forceinline__ unsigned f2bf(float f) { unsigned u = __builtin_bit_cast(unsigned, f); return (u + 0x7fffu + ((u >> 16) & 1u)) >> 16; }
__device__ __forceinline__ unsigned pk2(float lo, float hi) { return f2bf(lo) | (f2bf(hi) << 16); }
__device__ __forceinline__ float bf_lo(unsigned w) { return __builtin_bit_cast(float, w << 16); }
__device__ __forceinline__ float bf_hi(unsigned w) { return __builtin_bit_cast(float, w & 0xffff0000u); }
template <int CTRL> __device__ __forceinline__ float dpp_mov(float v) { return __builtin_bit_cast(float, __builtin_amdgcn_update_dpp(0, __builtin_bit_cast(int, v), CTRL, 0xf, 0xf, true)); }
#ifndef SAFE_SUM
#define SAFE_SUM 1
#endif
__device__ __forceinline__ float bperm_xor(float v, int m) { int l; asm volatile("v_mbcnt_lo_u32_b32 %0, -1, 0\n\tv_mbcnt_hi_u32_b32 %0, -1, %0" : "=v"(l));
    return __builtin_bit_cast(float, __builtin_amdgcn_ds_bpermute((l ^ m) << 2, __builtin_bit_cast(int, v))); }
__device__ __forceinline__ float sum_xor16(float v) { if (SAFE_SUM) return v + bperm_xor(v, 16); auto r = __builtin_amdgcn_permlane16_swap(__builtin_bit_cast(unsigned, v), __builtin_bit_cast(unsigned, v), false, false); return __builtin_bit_cast(float, r[0]) + __builtin_bit_cast(float, r[1]); }
__device__ __forceinline__ float sum_xor32(float v) { if (SAFE_SUM) return v + bperm_xor(v, 32); auto r = __builtin_amdgcn_permlane32_swap(__builtin_bit_cast(unsigned, v), __builtin_bit_cast(unsigned, v), false, false); return __builtin_bit_cast(float, r[0]) + __builtin_bit_cast(float, r[1]); }
__device__ __forceinline__ float max_xor32(float v) { if (SAFE_SUM) return fmaxf(v, bperm_xor(v, 32)); auto r = __builtin_amdgcn_permlane32_swap(__builtin_bit_cast(unsigned, v), __builtin_bit_cast(unsigned, v), false, false); return fmaxf(__builtin_bit_cast(float, r[0]), __builtin_bit_cast(float, r[1])); }
__device__ __forceinline__ int lane_id_asm();
__device__ __forceinline__ float wave_sum_bperm(float v) {
    int l; asm volatile("v_mbcnt_lo_u32_b32 %0, -1, 0\n\tv_mbcnt_hi_u32_b32 %0, -1, %0" : "=v"(l));
#pragma unroll
    for (int m = 1; m < 64; m <<= 1) v += __builtin_bit_cast(float, __builtin_amdgcn_ds_bpermute((l ^ m) << 2, __builtin_bit_cast(int, v)));
    return v;
}
__device__ __forceinline__ float wave_sum_dpp(float v) {
    v += dpp_mov<0xB1>(v);
    v += dpp_mov<0x4E>(v);
    v += dpp_mov<0x141>(v);
    v += dpp_mov<0x140>(v);
    return sum_xor32(sum_xor16(v));
}
__device__ __forceinline__ float wave_sum(float v) { return SAFE_SUM ? wave_sum_bperm(v) : wave_sum_dpp(v); }
__device__ __forceinline__ int lane_id_asm() { int l; asm volatile("v_mbcnt_lo_u32_b32 %0, -1, 0\n\tv_mbcnt_hi_u32_b32 %0, -1, %0" : "=v"(l)); return l; }
__device__ __forceinline__ float sigmoidf_(float x) { return __builtin_amdgcn_rcpf(1.0f + __builtin_amdgcn_exp2f(-x * LOG2E)); }

#ifndef DIAG
#define DIAG 0
#endif
constexpr int DIAGV = DIAG;
namespace pg8 {
#define PG8_LAS __attribute__((address_space(3)))
constexpr int BM = 256, BK = 64, HALF = 128, HTB = HALF * BK * 2  , STAGE_BYTES = 8 * HTB, NXCD = 8, WGM = 8;

__host__ __device__ __forceinline__ int lds_byte(int r, int c) { const int st = (r >> 4) * 2 + (c >> 5), rr = r & 15, cc = c & 31, ob = rr * 64 + cc * 2; return st * 1024 + (ob ^ (((ob >> 9) & 1) << 5)); }
__host__ __device__ __forceinline__ void stage_rc(int b, int& R, int& C) { const int st = b / 1024, sb = b % 1024, swz = sb ^ (((sb >> 9) & 1) << 5); R = (st >> 1) * 16 + swz / 64; C = (st & 1) * 32 + (swz % 64) / 2; }
__host__ __device__ __forceinline__ int perm32(int rho) { const int n = rho >> 4, i = rho & 15; return 8 * (i >> 2) + 4 * n + (i & 3); }

struct Unit { int pm, pn; long boff; };
struct Gemm { const bf16_t* A; const bf16_t* Bt; int M, N, K; };

struct StaticOrder {
    int nM, nN, nwg, G, c;
    __host__ __device__ void init(int M, int N, int G_, int c_) { nM = M / BM; nN = N / BM; nwg = nM * nN; G = G_; c = c_; }
    __host__ __device__ bool next(int i, Unit& u) const {
        const long L = (long)i * G + c; if (L >= nwg) return false;
        int wgid = (int)L; { const int q = nwg / NXCD, r = nwg % NXCD, xcd = wgid % NXCD, off = wgid / NXCD; wgid = (xcd < r ? xcd * (q + 1) : r * (q + 1) + (xcd - r) * q) + off; }
        const int nig = WGM * nN, gid = wgid / nig, fm = gid * WGM, gsz = (nM - fm) < WGM ? (nM - fm) : WGM;
        u.pm = fm + ((wgid % nig) % gsz); u.pn = (wgid % nig) / gsz; u.boff = 0; return true;
    }
    __device__ __forceinline__ void a_ready(const Unit&) const {}
    __device__ __forceinline__ void done(const Unit&) const {}
};
__device__ __forceinline__ unsigned cvt_pk_bf16(float lo, float hi) { unsigned r; asm volatile("v_cvt_pk_bf16_f32 %0, %1, %2" : "=v"(r) : "v"(lo), "v"(hi)); return r; }


__device__ __forceinline__ u32x4 pack8(const f32x4& v0, const f32x4& v1) { u32x4 w; w.x = cvt_pk_bf16(v0[0], v0[1]); w.y = cvt_pk_bf16(v0[2], v0[3]); w.z = cvt_pk_bf16(v1[0], v1[1]); w.w = cvt_pk_bf16(v1[2], v1[3]); return w; }
__device__ __forceinline__ void unpack8(const u32x4& w, f32x4& v0, f32x4& v1) { v0[0] = bf_lo(w.x); v0[1] = bf_hi(w.x); v0[2] = bf_lo(w.y); v0[3] = bf_hi(w.y); v1[0] = bf_lo(w.z); v1[1] = bf_hi(w.z); v1[2] = bf_lo(w.w); v1[3] = bf_hi(w.w); }

struct EpiProj {
    static constexpr bool PERM = true, AFTER_DRAIN = false;
    bf16_t* U; bf16_t* QKV; bf16_t* G; float qscale;
    __device__ __forceinline__ void operator()(const f32x4 (&acc)[2][2][4][2], const Unit& u, int wr, int wc, int fr, int fq) const {
        const int pn = u.pn;
        const int row0 = u.pm * BM + wr * 64 + fr;
        const int cin0 = wc * 32 + 8 * fq;
        if (pn < 2 || pn >= 11) {
            bf16_t* base; int ldc, c0;
            if (pn < 2) { base = U; ldc = POOLW; c0 = pn * BM; } else { base = G; ldc = 2 * DM; c0 = (pn - 11) * BM; }
#pragma unroll
            for (int ai = 0; ai < 2; ++ai)
#pragma unroll
                for (int m = 0; m < 4; ++m) { bf16_t* rowp = base + (size_t)(row0 + ai * HALF + m * 16) * ldc + c0 + cin0;
#pragma unroll
                    for (int bj = 0; bj < 2; ++bj) *(u32x4*)(rowp + bj * HALF) = pack8(acc[ai][bj][m][0], acc[ai][bj][m][1]); }
        } else {
            const int which = (pn - 2) / 3, grp = (pn - 2) % 3, sh = 2 * grp;
            bf16_t* base = QKV + (size_t)which * ((size_t)NB * NHEAD * SEQ * HD);
            const float sc = which == 0 ? qscale : 1.0f;
            const int sublen = SEQ >> sh;
#pragma unroll
            for (int ai = 0; ai < 2; ++ai)
#pragma unroll
                for (int m = 0; m < 4; ++m) { const int row = row0 + ai * HALF + m * 16; const int b = row / SEQ, t = row % SEQ;
                    const int pos = (t & ((1 << sh) - 1)) * sublen + (t >> sh);
#pragma unroll
                    for (int bj = 0; bj < 2; ++bj) { const int cin = bj * HALF + cin0; const int head = grp * 4 + (cin >> 6), dcol = cin & 63;
                        bf16_t* dst = base + ((size_t)(b * NHEAD + head) * SEQ + pos) * HD + dcol;
                        *(u32x4*)dst = pack8(acc[ai][bj][m][0] * sc, acc[ai][bj][m][1] * sc); } }
        }
    }
};
struct EpiGate1 {
    static constexpr bool PERM = true, AFTER_DRAIN = false;
    const bf16_t* G; bf16_t* TMP;
    __device__ __forceinline__ void operator()(const f32x4 (&acc)[2][2][4][2], const Unit& u, int wr, int wc, int fr, int fq) const {
        const int row0 = u.pm * BM + wr * 64 + fr, col0 = u.pn * BM + wc * 32 + 8 * fq;
#pragma unroll
        for (int ai = 0; ai < 2; ++ai)
#pragma unroll
            for (int m = 0; m < 4; ++m) { const size_t row = (size_t)(row0 + ai * HALF + m * 16);
#pragma unroll
                for (int bj = 0; bj < 2; ++bj) { const int col = col0 + bj * HALF;
                    const u32x4 gw = *(const u32x4*)(G + row * (2 * DM) + col); f32x4 g0, g1; unpack8(gw, g0, g1);
                    f32x4 v0 = acc[ai][bj][m][0], v1 = acc[ai][bj][m][1];
#pragma unroll
                    for (int j = 0; j < 4; ++j) { v0[j] *= sigmoidf_(g0[j]); v1[j] *= sigmoidf_(g1[j]); }
                    *(u32x4*)(TMP + row * DM + col) = pack8(v0, v1); } }
    }
};
struct EpiGate2 {
    static constexpr bool PERM = true, AFTER_DRAIN = false;
    const bf16_t* G; const bf16_t* TMP; bf16_t* OUT;
    __device__ __forceinline__ void operator()(const f32x4 (&acc)[2][2][4][2], const Unit& u, int wr, int wc, int fr, int fq) const {
        const int row0 = u.pm * BM + wr * 64 + fr, col0 = u.pn * BM + wc * 32 + 8 * fq;
#pragma unroll
        for (int ai = 0; ai < 2; ++ai)
#pragma unroll
            for (int m = 0; m < 4; ++m) { const size_t row = (size_t)(row0 + ai * HALF + m * 16);
#pragma unroll
                for (int bj = 0; bj < 2; ++bj) { const int col = col0 + bj * HALF;
                    const u32x4 gw = *(const u32x4*)(G + row * (2 * DM) + DM + col); f32x4 g0, g1; unpack8(gw, g0, g1);
                    const u32x4 tw = *(const u32x4*)(TMP + row * DM + col); f32x4 t0, t1; unpack8(tw, t0, t1);
                    f32x4 v0 = acc[ai][bj][m][0], v1 = acc[ai][bj][m][1];
#pragma unroll
                    for (int j = 0; j < 4; ++j) { v0[j] = t0[j] + (DIAGV == 2 ? 0.f : 1.f) * v0[j] * sigmoidf_(g0[j]); v1[j] = t1[j] + (DIAGV == 2 ? 0.f : 1.f) * v1[j] * sigmoidf_(g1[j]); }
                    *(u32x4*)(OUT + row * DM + col) = pack8(v0, v1); } }
    }
};
struct EpiY {
    static constexpr bool PERM = true, AFTER_DRAIN = false;
    bf16_t* Y; float* YSTAT;
    __device__ __forceinline__ void operator()(const f32x4 (&acc)[2][2][4][2], const Unit& u, int wr, int wc, int fr, int fq) const {
        const int row0 = u.pm * BM + wr * 64 + fr, col0 = u.pn * BM + wc * 32 + 8 * fq;
#pragma unroll
        for (int ai = 0; ai < 2; ++ai)
#pragma unroll
            for (int m = 0; m < 4; ++m) { const size_t row = (size_t)(row0 + ai * HALF + m * 16); float s = 0.f;
#pragma unroll
                for (int bj = 0; bj < 2; ++bj) { const f32x4 v0 = acc[ai][bj][m][0], v1 = acc[ai][bj][m][1];
                    s += (v0[0] * v0[0] + v0[1] * v0[1]) + (v0[2] * v0[2] + v0[3] * v0[3]) + (v1[0] * v1[0] + v1[1] * v1[1]) + (v1[2] * v1[2] + v1[3] * v1[3]);
                    *(u32x4*)(Y + row * DM + col0 + bj * HALF) = pack8(v0, v1); }
                s = sum_xor32(sum_xor16(s));
                if (fq == 0) YSTAT[row * 16 + u.pn * 4 + wc] = s; }
    }
};
struct EpiAct {
    static constexpr bool PERM = true, AFTER_DRAIN = false;
    bf16_t* ACT;
    __device__ __forceinline__ void operator()(const f32x4 (&acc)[2][2][4][2], const Unit& u, int wr, int wc, int fr, int fq) const {
        const int row0 = u.pm * BM + wr * 64 + fr, col0 = u.pn * 128 + wc * 16 + 4 * fq;
#pragma unroll
        for (int ai = 0; ai < 2; ++ai)
#pragma unroll
            for (int m = 0; m < 4; ++m) { const size_t row = (size_t)(row0 + ai * HALF + m * 16);
#pragma unroll
                for (int bj = 0; bj < 2; ++bj) { const f32x4 g = acc[ai][bj][m][0], up = acc[ai][bj][m][1]; float a[4];
#pragma unroll
                    for (int j = 0; j < 4; ++j) a[j] = g[j] * sigmoidf_(g[j]) * up[j];
                    u32x2 w; w.x = cvt_pk_bf16(a[0], a[1]); w.y = cvt_pk_bf16(a[2], a[3]);
                    *(u32x2*)(ACT + row * DEXP + col0 + bj * 64) = w; } }
    }
};
struct EpiDown {
    static constexpr bool PERM = true, AFTER_DRAIN = false;
    const int* SLOT_TK; const float* SLOT_W; bf16_t* CONTRIB;
    __device__ __forceinline__ void operator()(const f32x4 (&acc)[2][2][4][2], const Unit& u, int wr, int wc, int fr, int fq) const {
        const int row0 = u.pm * BM + wr * 64 + fr, col0 = u.pn * BM + wc * 32 + 8 * fq;
#pragma unroll
        for (int ai = 0; ai < 2; ++ai)
#pragma unroll
            for (int m = 0; m < 4; ++m) { const int row = row0 + ai * HALF + m * 16; const int tk = SLOT_TK[row]; const float w = SLOT_W[row];
                if (tk >= 0) {
#pragma unroll
                    for (int bj = 0; bj < 2; ++bj) *(u32x4*)(CONTRIB + (size_t)tk * DM + col0 + bj * HALF) = pack8(acc[ai][bj][m][0] * w, acc[ai][bj][m][1] * w); } }
    }
};

template <class Epi, class Sched, bool ALIGN_EPI = false, bool SP2 = false>
__device__ __forceinline__ void gemm_phase(PG8_LAS unsigned char* lds, const Gemm g, const Sched& S, const Epi& E, const int wave_sgpr) {
    int tid_ = wave_sgpr * 64 + lane_id_asm();
    const int tid = tid_, wid = __builtin_amdgcn_readfirstlane(tid >> 6), lane = tid & 63, wr = wid >> 2, wc = wid & 3, fr = lane & 15, fq = lane >> 4;
    int K_ = g.K; asm volatile("" : "+s"(K_));
    const int K = K_, nt = K / BK;
    unsigned voffA[2], voffB[2];
#pragma unroll
    for (int i = 0; i < 2; ++i) { int R, C; stage_rc(tid * 16 + i * 8192, R, C); const int Rb = Epi::PERM ? ((R & ~31) + perm32(R & 31)) : R;
        voffA[i] = (unsigned)(R * K + C) * 2u; voffB[i] = (unsigned)(Rb * K + C) * 2u; }
    const size_t kstep = (size_t)(BK * 2);
    const size_t hstep = (size_t)HALF * K * 2;
    const size_t tstep = 2 * hstep;
    const unsigned ldsw = (unsigned)wid * 1024u;
    const int aoff = lds_byte(wr * 64 + fr, fq * 8), boff = lds_byte(wc * 32 + fr, fq * 8);
#define PG8_SA(b, h) (((b) * 2 + (h)) * HTB)
#define PG8_SB(b, h) ((4 + (b) * 2 + (h)) * HTB)
#define PG8_STAGE(bufoff, gbase, voff) do { _Pragma("unroll") for (int _i = 0; _i < 2; ++_i) \
        __builtin_amdgcn_global_load_lds((const unsigned*)((const char*)(gbase) + (voff)[_i]), (PG8_LAS unsigned*)(lds + (bufoff) + ldsw + _i * 8192), 16, 0, 0); } while (0)
#define PG8_LDA(dst, b, h) do { _Pragma("unroll") for (int m = 0; m < 4; ++m) _Pragma("unroll") for (int k = 0; k < 2; ++k) dst[m][k] = *(const PG8_LAS bf16x8*)(lds + PG8_SA(b, h) + aoff + m * 2048 + k * 1024); } while (0)
#define PG8_LDB(dst, b, h) do { _Pragma("unroll") for (int n = 0; n < 2; ++n) _Pragma("unroll") for (int k = 0; k < 2; ++k) dst[n][k] = *(const PG8_LAS bf16x8*)(lds + PG8_SB(b, h) + boff + n * 2048 + k * 1024); } while (0)
#define PG8_MMA(ai, bj, At, Bt) do { __builtin_amdgcn_s_setprio(1); _Pragma("unroll") for (int m = 0; m < 4; ++m) _Pragma("unroll") for (int n = 0; n < 2; ++n) _Pragma("unroll") for (int k = 0; k < 2; ++k) \
        acc[ai][bj][m][n] = __builtin_amdgcn_mfma_f32_16x16x32_bf16(Bt[n][k], At[m][k], acc[ai][bj][m][n], 0, 0, 0); __builtin_amdgcn_s_setprio(0); } while (0)
#define PG8_WAIT_V(n) asm volatile("s_waitcnt vmcnt(" #n ")" ::: "memory")
#define PG8_WAIT_L(n) asm volatile("s_waitcnt lgkmcnt(" #n ")" ::: "memory")
#define PG8_BAR __builtin_amdgcn_s_barrier()
#define PG8_SCHED __builtin_amdgcn_sched_barrier(0)
    Unit cur, nxt; int ui = 0;
    if (!S.next(0, cur)) return;
    f32x4 acc[2][2][4][2];
#pragma unroll
    for (int a = 0; a < 2; ++a)
#pragma unroll
        for (int b = 0; b < 2; ++b)
#pragma unroll
            for (int m = 0; m < 4; ++m)
#pragma unroll
                for (int n = 0; n < 2; ++n) acc[a][b][m][n] = (f32x4){0.f, 0.f, 0.f, 0.f};
    bf16x8 At[4][2], B0[2][2], B1[2][2];
    const char* cA = (const char*)g.A + (size_t)cur.pm * tstep; const char* cB = (const char*)g.Bt + (size_t)cur.boff * 2 + (size_t)cur.pn * tstep;
    S.a_ready(cur);
    if constexpr (SP2) {
        PG8_STAGE(PG8_SB(0, 0), cB, voffB); PG8_STAGE(PG8_SB(0, 1), cB + hstep, voffB); PG8_STAGE(PG8_SA(0, 0), cA, voffA); PG8_STAGE(PG8_SA(0, 1), cA + hstep, voffA);
        if (wr == 1) PG8_BAR;
        PG8_WAIT_V(2); PG8_BAR;
        PG8_STAGE(PG8_SB(1, 0), cB + kstep, voffB); PG8_STAGE(PG8_SA(1, 0), cA + kstep, voffA); PG8_STAGE(PG8_SB(1, 1), cB + hstep + kstep, voffB);
        PG8_WAIT_V(6); PG8_BAR;
    } else {
        PG8_STAGE(PG8_SB(0, 0), cB, voffB); PG8_STAGE(PG8_SA(0, 0), cA, voffA); PG8_STAGE(PG8_SB(0, 1), cB + hstep, voffB); PG8_STAGE(PG8_SA(0, 1), cA + hstep, voffA);
        if (wr == 1) PG8_BAR;
        PG8_WAIT_V(4); PG8_BAR;
        PG8_STAGE(PG8_SB(1, 0), cB + kstep, voffB); PG8_STAGE(PG8_SA(1, 0), cA + kstep, voffA); PG8_STAGE(PG8_SB(1, 1), cB + hstep + kstep, voffB);
        PG8_WAIT_V(6); PG8_BAR;
    }
    for (;;) {
        const bool has_next = S.next(ui + 1, nxt);
        const char* nA = has_next ? (const char*)g.A + (size_t)nxt.pm * tstep : cA; const char* nB = has_next ? (const char*)g.Bt + (size_t)nxt.boff * 2 + (size_t)nxt.pn * tstep : cB;
        for (int t = 0; t < nt; t += 2) {
            const bool last = (t == nt - 2);
            const char* a1 = cA + (size_t)(t + 1) * kstep;
            const char* a2 = last ? nA : cA + (size_t)(t + 2) * kstep; const char* b2 = last ? nB : cB + (size_t)(t + 2) * kstep;
            const char* a3 = a2 + kstep; const char* b3 = b2 + kstep;
            if (last && has_next) S.a_ready(nxt);
            if constexpr (SP2) {
            PG8_LDB(B0, 0, 0); PG8_LDB(B1, 0, 1); PG8_SCHED; PG8_LDA(At, 0, 0); PG8_STAGE(PG8_SA(1, 1), a1 + hstep, voffA);
            PG8_WAIT_V(8); PG8_WAIT_L(0); PG8_BAR; PG8_MMA(0, 0, At, B0); PG8_MMA(0, 1, At, B1); PG8_BAR; PG8_SCHED;
            PG8_LDA(At, 0, 1); PG8_STAGE(PG8_SB(0, 0), b2, voffB); PG8_STAGE(PG8_SB(0, 1), b2 + hstep, voffB); PG8_STAGE(PG8_SA(0, 0), a2, voffA);
            PG8_WAIT_V(8); PG8_WAIT_L(0); PG8_BAR; PG8_MMA(1, 0, At, B0); PG8_MMA(1, 1, At, B1); PG8_BAR; PG8_SCHED;
            PG8_LDB(B0, 1, 0); PG8_LDB(B1, 1, 1); PG8_SCHED; PG8_LDA(At, 1, 0); PG8_STAGE(PG8_SA(0, 1), a2 + hstep, voffA);
            PG8_WAIT_V(8); PG8_WAIT_L(0); PG8_BAR; PG8_MMA(0, 0, At, B0); PG8_MMA(0, 1, At, B1); PG8_BAR; PG8_SCHED;
            PG8_LDA(At, 1, 1); PG8_STAGE(PG8_SB(1, 0), b3, voffB); PG8_STAGE(PG8_SB(1, 1), b3 + hstep, voffB); PG8_STAGE(PG8_SA(1, 0), a3, voffA);
            PG8_WAIT_V(8); PG8_WAIT_L(0); PG8_BAR; PG8_MMA(1, 0, At, B0); PG8_MMA(1, 1, At, B1); PG8_BAR; PG8_SCHED;
            } else {
            PG8_LDB(B0, 0, 0); PG8_SCHED; PG8_LDA(At, 0, 0); PG8_STAGE(PG8_SA(1, 1), a1 + hstep, voffA);
            PG8_WAIT_L(8); PG8_BAR; PG8_WAIT_L(0); PG8_MMA(0, 0, At, B0); PG8_BAR; PG8_SCHED;
            PG8_LDB(B1, 0, 1); PG8_STAGE(PG8_SB(0, 0), b2, voffB);
            PG8_BAR; PG8_WAIT_L(0); PG8_MMA(0, 1, At, B1); PG8_BAR;
            PG8_LDA(At, 0, 1); PG8_STAGE(PG8_SA(0, 0), a2, voffA);
            PG8_BAR; PG8_WAIT_L(0); PG8_MMA(1, 0, At, B0); PG8_BAR; PG8_SCHED;
            PG8_STAGE(PG8_SB(0, 1), b2 + hstep, voffB);
            PG8_WAIT_V(6); PG8_BAR; PG8_MMA(1, 1, At, B1); PG8_BAR;
            PG8_LDB(B0, 1, 0); PG8_SCHED; PG8_LDA(At, 1, 0); PG8_STAGE(PG8_SA(0, 1), a2 + hstep, voffA);
            PG8_WAIT_L(8); PG8_BAR; PG8_WAIT_L(0); PG8_MMA(0, 0, At, B0); PG8_BAR; PG8_SCHED;
            PG8_LDB(B1, 1, 1); PG8_STAGE(PG8_SB(1, 0), b3, voffB);
            PG8_BAR; PG8_WAIT_L(0); PG8_MMA(0, 1, At, B1); PG8_BAR;
            PG8_LDA(At, 1, 1); PG8_STAGE(PG8_SA(1, 0), a3, voffA);
            PG8_BAR; PG8_WAIT_L(0); PG8_MMA(1, 0, At, B0); PG8_BAR; PG8_SCHED;
            PG8_STAGE(PG8_SB(1, 1), b3 + hstep, voffB);
            PG8_WAIT_V(6); PG8_BAR; PG8_MMA(1, 1, At, B1); PG8_BAR;
            }
        }
        if constexpr (ALIGN_EPI) { if (wr == 0) PG8_BAR; }
        if constexpr (!Epi::AFTER_DRAIN) { E(acc, cur, wr, wc, fr, fq); S.done(cur); }
        if (!has_next) break;
#pragma unroll
        for (int a = 0; a < 2; ++a)
#pragma unroll
            for (int b = 0; b < 2; ++b)
#pragma unroll
                for (int m = 0; m < 4; ++m)
#pragma unroll
                    for (int n = 0; n < 2; ++n) acc[a][b][m][n] = (f32x4){0.f, 0.f, 0.f, 0.f};
        cur = nxt; cA = nA; cB = nB; ++ui;
        if constexpr (ALIGN_EPI) { if (wr == 1) PG8_BAR; }
    }
    PG8_WAIT_V(0);
    if constexpr (!ALIGN_EPI) { if (wr == 0) PG8_BAR; }
    PG8_BAR;
    if constexpr (Epi::AFTER_DRAIN) { E.fused(acc, cur, wr, wc, fr, fq, lds, wid, lane); S.done(cur); }
#undef PG8_SA
#undef PG8_SB
#undef PG8_STAGE
#undef PG8_LDA
#undef PG8_LDB
#undef PG8_MMA
#undef PG8_WAIT_V
#undef PG8_WAIT_L
#undef PG8_BAR
#undef PG8_SCHED
}
}

constexpr size_t MiB = 1u << 20;
constexpr size_t WS_CTL = 0, CTL_ZERO_BYTES = 1 * MiB;
constexpr size_t WS_MODP = 1 * MiB;
constexpr size_t WS_MOD = WS_MODP + 8 * 4 * 6144 * 4;
constexpr size_t WS_SMALL = 2 * MiB;
constexpr size_t WS_LIST_TK = WS_SMALL, WS_LIST_W = WS_SMALL + 2 * MiB;
constexpr size_t WS_WIN = 6 * MiB;
constexpr size_t WS_WFOLD = 16 * MiB, WS_WBA = 17 * MiB, WS_WOUT = 18 * MiB;
constexpr size_t WS_W1 = 20 * MiB;
constexpr size_t WS_W2 = 84 * MiB;
constexpr size_t WS_A = 116 * MiB;
constexpr size_t WS_G = WS_A;
constexpr size_t WS_QS = WS_A + 64 * MiB, WS_KS = WS_QS + 24 * MiB, WS_VS = WS_KS + 24 * MiB;
constexpr size_t WS_U = WS_A + 136 * MiB;
constexpr size_t WS_H = WS_A + 152 * MiB;
constexpr size_t WS_OG0 = WS_WIN;
constexpr size_t WS_LSE = WS_WIN + 8 * MiB;
constexpr size_t WS_OG12 = WS_H;
constexpr size_t WS_POOLED = WS_H + 16 * MiB;
constexpr size_t WS_TMP = WS_A + 64 * MiB;
constexpr size_t WS_OC = WS_A + 96 * MiB;
constexpr size_t WS_MERGED = WS_A + 104 * MiB;
constexpr size_t WS_Y = WS_A;
constexpr size_t WS_YSTAT = WS_A + 136 * MiB;
constexpr size_t WS_H2 = WS_A + 32 * MiB;
constexpr size_t WS_XS = WS_A + 64 * MiB;
constexpr size_t WS_SLOT_TK = WS_A + 144 * MiB, WS_SLOT_W = WS_A + 145 * MiB;
constexpr size_t WS_ACT = WS_A;
constexpr size_t WS_CONTRIB = WS_A + 64 * MiB;
constexpr size_t WS_END = WS_A + 184 * MiB;
constexpr int CW_ECOUNT = 64;
constexpr int CW_BAR = 4096;

constexpr int RING_BYTES = 131072;
constexpr int LDS_BYTES = 163840;
constexpr int MISC_OFF = LDS_BYTES - 512;
constexpr int SEG_OFF = LDS_BYTES - 1024;
constexpr int NWAVES = 8;

#define RLX_AGENT __ATOMIC_RELAXED, __HIP_MEMORY_SCOPE_AGENT
#define LDS_WAIT() asm volatile("s_waitcnt lgkmcnt(0)" ::: "memory")
#define VM_WAIT() asm volatile("s_waitcnt vmcnt(0)" ::: "memory")
typedef GAS unsigned gu32;
#define XB_TMO      128
#define XB_XCNT(j)  (256  + 64 * (j))
#define XB_XSUB(j)  (1280 + 64 * (j))
#define XB_XGEN(j)  (2304 + 64 * (j))
#define XB_TOP      3328
#define XB_TOPGEN   3392
#define XCD_BAR_WORDS 3456
#define XB_SPIN_CAP (1u << 18)

__device__ __forceinline__ unsigned xb_ld(unsigned* p)              { return __hip_atomic_load(p, __ATOMIC_RELAXED, __HIP_MEMORY_SCOPE_AGENT); }
__device__ __forceinline__ unsigned xb_add(unsigned* p, unsigned v) { return __hip_atomic_fetch_add(p, v, __ATOMIC_RELAXED, __HIP_MEMORY_SCOPE_AGENT); }
__device__ __forceinline__ unsigned xb_xcc_id() { return (unsigned)__builtin_amdgcn_s_getreg((3 << 11) | 20) & 0xFu; }
#define XB_SPIN(cond, bar) do { unsigned _sp = 0; while (cond) { __builtin_amdgcn_s_sleep(1); \
    if ((++_sp & 255u) == 0u) { if (xb_ld(&(bar)[XB_TMO])) break; if (_sp > XB_SPIN_CAP) { atomicAdd(&(bar)[XB_TMO], 1u); break; } } } } while (0)

struct XcdBarrier {
    unsigned* bar; unsigned x;
    volatile LAS unsigned* st;
};

__device__ __forceinline__ XcdBarrier xcd_barrier_post(unsigned* bar, volatile LAS unsigned* st, bool t0) {
    XcdBarrier b; b.bar = bar; b.x = xb_xcc_id(); b.st = st;
    if (t0) (void)xb_add(&bar[XB_XCNT(b.x)], 1u);
    return b;
}
__device__ __forceinline__ void xcd_barrier_complete(unsigned* bar, unsigned x, unsigned& nloc, unsigned& nx) {
    const unsigned G = gridDim.x * gridDim.y * gridDim.z;
    unsigned sum, cnt, mine, sp = 0u;
    for (;;) {
        sum = 0u; cnt = 0u; mine = 0u;
#pragma unroll
        for (unsigned j = 0; j < 16; ++j) { const unsigned c = xb_ld(&bar[XB_XCNT(j)]); sum += c; cnt += (c > 0u) ? 1u : 0u; mine = (j == x) ? c : mine; }
        if (sum == G) break;
        __builtin_amdgcn_s_sleep(1);
        if ((++sp & 255u) == 0u) { if (xb_ld(&bar[XB_TMO])) break; if (sp > XB_SPIN_CAP) { atomicAdd(&bar[XB_TMO], 1u); break; } }
    }
    nloc = mine > 0u ? mine : 1u; nx = cnt > 0u ? cnt : 1u;
}

__device__ __forceinline__ void xcd_barrier(const XcdBarrier& b, bool t0) {
    asm volatile("s_waitcnt vmcnt(0)" ::: "memory");
    __syncthreads();
    if (t0) {
        unsigned* bar = b.bar;
        __builtin_amdgcn_s_waitcnt(0);
        unsigned nloc = b.st[0], nx = b.st[1];
        if (nloc == 0u) { xcd_barrier_complete(bar, b.x, nloc, nx); b.st[0] = nloc; b.st[1] = nx; }
        const unsigned old = xb_add(&bar[XB_XSUB(b.x)], 1u);
        const unsigned gen = old / nloc;
        if (old + 1u == (gen + 1u) * nloc) {
            __builtin_amdgcn_fence(__ATOMIC_RELEASE, "agent");
            asm volatile("s_waitcnt vmcnt(0)" ::: "memory");
            const unsigned og = xb_add(&bar[XB_TOP], 1u);
            const unsigned tg = og / nx;
            if (og + 1u == (tg + 1u) * nx) xb_add(&bar[XB_TOPGEN], 1u);
            else XB_SPIN(xb_ld(&bar[XB_TOPGEN]) == tg, bar);
            __builtin_amdgcn_fence(__ATOMIC_ACQUIRE, "agent");
            xb_add(&bar[XB_XGEN(b.x)], 1u);
            asm volatile("s_waitcnt vmcnt(0)" ::: "memory");
        } else {
            XB_SPIN(xb_ld(&bar[XB_XGEN(b.x)]) == gen, bar);
            __builtin_amdgcn_fence(__ATOMIC_ACQUIRE, "agent");
            asm volatile("s_waitcnt vmcnt(0)" ::: "memory");
        }
    }
    __syncthreads();
}


struct Args {
    const float* x; const float* c; const float* w_ada; const float* b_ada;
    const float* g_pre_mix; const float* g_post_mix; const float* g_pre_ffn; const float* g_post_ffn;
    const float* w_in; const float* w_pool_group; const float* pool_scale; const float* w_branch_pool; const float* w_branch_att; const float* w_out;
    const float* w_group_router; const float* b_group_router; const float* w_expert_router; const float* b_expert_router;
    const float* w_exp_gate; const float* w_exp_up; const float* w_exp_down;
    float* out; unsigned char* ws;
};
struct Frame {
    LAS unsigned char* lds;
    int tid, lane, wave, G, vcu;
};

struct TDesc { const float* src; bf16_t* dst; int K, N, map; };
__device__ __forceinline__ int t_rowmap(int n, int map) { return map == 0 ? n : ((n >> 2) * 8 + (n & 3) + (map == 2 ? 4 : 0)); }
__device__ __forceinline__ void t_load(const TDesc& d, int n0, f32x4 (&v)[16], int lane) {
    const float* p = d.src + (size_t)(lane >> 4) * d.N + 4 * (lane & 15);
#pragma unroll
    for (int i = 0; i < 16; ++i) v[i] = *(const f32x4*)(p + (size_t)(4 * i) * d.N);
}
__device__ __forceinline__ void t_flush(const TDesc& d, int n0, const f32x4 (&v)[16], LAS float* scr, int lane) {
#pragma unroll
    for (int i = 0; i < 16; ++i) { const int k = 4 * i + (lane >> 4), nq = 4 * (lane & 15); *(LAS f32x4*)(scr + k * 64 + (nq ^ (((k >> 3) & 7) << 2))) = v[i]; }
    LDS_WAIT(); asm volatile("" ::: "memory");
    const int c = lane & 7, nn = lane >> 3;
#pragma unroll
    for (int j = 0; j < 8; ++j) { const int n = nn + 8 * j; const LAS float* sp = scr + (8 * c) * 64 + (n ^ (c << 2));
        u32x4 o; o.x = pk2(sp[0 * 64], sp[1 * 64]); o.y = pk2(sp[2 * 64], sp[3 * 64]); o.z = pk2(sp[4 * 64], sp[5 * 64]); o.w = pk2(sp[6 * 64], sp[7 * 64]);
        *(GAS u32x4*)(d.dst + (size_t)t_rowmap(n0 + n, d.map) * d.K + 8 * c) = o; }
    LDS_WAIT(); asm volatile("" ::: "memory");
}

__device__ __forceinline__ void p0_gemv_item(const Frame& F, const Args& a, int item) {
    const int cc = item % 24, kg = item / 24;
    const int col = cc * 256 + 4 * F.lane, kbase = kg * 128 + F.wave * 16;
    f32x4 acc[4] = {{0.f, 0.f, 0.f, 0.f}, {0.f, 0.f, 0.f, 0.f}, {0.f, 0.f, 0.f, 0.f}, {0.f, 0.f, 0.f, 0.f}};
#pragma unroll 4
    for (int i = 0; i < 16; ++i) { const int k = kbase + i; const f32x4 w = *(const f32x4*)(a.w_ada + (size_t)k * 6144 + col);
#pragma unroll
        for (int b = 0; b < 4; ++b) { const float cv = a.c[b * DM + k]; const float s = cv * sigmoidf_(cv); acc[b] += w * s; } }
    LAS f32x4* red = (LAS f32x4*)F.lds;
#pragma unroll
    for (int b = 0; b < 4; ++b) red[(F.wave * 4 + b) * 64 + F.lane] = acc[b];
    __syncthreads();
    if (F.tid < 256) { const int b = F.tid >> 6, l = F.tid & 63; f32x4 s = red[b * 64 + l];
#pragma unroll
        for (int w = 1; w < 8; ++w) s += red[(w * 4 + b) * 64 + l];
        *(f32x4*)((float*)(a.ws + WS_MODP) + (size_t)(kg * 4 + b) * 6144 + cc * 256 + 4 * l) = s; }
    __syncthreads();
}
__device__ __forceinline__ void p0_fold_item(const Frame& F, const Args& a, int item) {
    const int g = item >> 4, d0 = (item & 15) * 64;
    LAS float* sWg = (LAS float*)F.lds;
    LAS float* sWb = sWg + 128 * 129;
    for (int i = F.tid; i < 128 * 128; i += 512) { const int c = i >> 7, j = i & 127; sWg[c * 129 + j] = a.w_pool_group[(size_t)g * 16384 + i]; }
    for (int i = F.tid; i < 128 * 64; i += 512) { const int j = i >> 6, d = i & 63; sWb[i] = a.pool_scale[g * 128 + j] * a.w_branch_pool[(size_t)(g * 128 + j) * DM + d0 + d]; }
    __syncthreads();
    const int d = F.tid & 63, cg0 = (F.tid >> 6) * 16;
    float acc[16];
#pragma unroll
    for (int i = 0; i < 16; ++i) acc[i] = 0.f;
    for (int j = 0; j < 128; ++j) { const float wb = sWb[j * 64 + d];
#pragma unroll
        for (int i = 0; i < 16; ++i) acc[i] += sWg[(cg0 + i) * 129 + j] * wb; }
    bf16_t* dst = (bf16_t*)(a.ws + WS_WFOLD) + (size_t)(d0 + d) * POOLW + g * 128 + cg0;
    u32x4 o0, o1;
    o0.x = pk2(acc[0], acc[1]); o0.y = pk2(acc[2], acc[3]); o0.z = pk2(acc[4], acc[5]); o0.w = pk2(acc[6], acc[7]);
    o1.x = pk2(acc[8], acc[9]); o1.y = pk2(acc[10], acc[11]); o1.z = pk2(acc[12], acc[13]); o1.w = pk2(acc[14], acc[15]);
    *(u32x4*)dst = o0; *(u32x4*)(dst + 8) = o1;
    __syncthreads();
}
__device__ __forceinline__ void p0_prologue(const Frame& F, const Args& a) {
    for (int it = F.vcu; it < 256; it += F.G) { if (it < 192) p0_gemv_item(F, a, it); else p0_fold_item(F, a, it - 192); }
    __syncthreads();
    LAS float* scr = (LAS float*)(F.lds + F.wave * 16384);
    const int gw = F.vcu * NWAVES + F.wave, NGW = F.G * NWAVES;
    constexpr int I_IN = (DM / 64) * (NIN / 64), I_BA = (256 / 64) * (DM / 64), I_OUT = (DM / 64) * (DM / 64);
    constexpr int I_GU = (DM / 64) * (DEXP / 64), I_DN = (DEXP / 64) * (DM / 64);
    constexpr int NITEMS = I_IN + I_BA + I_OUT + NEXP * (2 * I_GU + I_DN);
    auto decode = [&](int it, TDesc& d, int& n0) {
        int r = it; const float* W; bf16_t* WT; int K, N, map = 0;
        if (r < I_IN) { W = a.w_in; WT = (bf16_t*)(a.ws + WS_WIN); K = DM; N = NIN; }
        else if ((r -= I_IN) < I_BA) { W = a.w_branch_att; WT = (bf16_t*)(a.ws + WS_WBA); K = 256; N = DM; }
        else if ((r -= I_BA) < I_OUT) { W = a.w_out; WT = (bf16_t*)(a.ws + WS_WOUT); K = DM; N = DM; }
        else { r -= I_OUT; const int e = r / (2 * I_GU + I_DN); r -= e * (2 * I_GU + I_DN);
            if (r < I_GU) { W = a.w_exp_gate + (size_t)e * DM * DEXP; WT = (bf16_t*)(a.ws + WS_W1) + (size_t)e * DM * DM; K = DM; N = DEXP; map = 1; }
            else if ((r -= I_GU) < I_GU) { W = a.w_exp_up + (size_t)e * DM * DEXP; WT = (bf16_t*)(a.ws + WS_W1) + (size_t)e * DM * DM; K = DM; N = DEXP; map = 2; }
            else { r -= I_GU; W = a.w_exp_down + (size_t)e * DEXP * DM; WT = (bf16_t*)(a.ws + WS_W2) + (size_t)e * DM * DEXP; K = DEXP; N = DM; } }
        const int nblk = N / 64, kb = r / nblk, nb = r % nblk; n0 = nb * 64;
        d.src = W + (size_t)(kb * 64) * N + n0; d.dst = WT + kb * 64; d.K = K; d.N = N; d.map = map; };
    TDesc dA, dB; int nA = 0, nB = 0; f32x4 vA[16], vB[16];
    int it = gw;
    if (it < NITEMS) { decode(it, dA, nA); t_load(dA, nA, vA, F.lane); }
    while (it < NITEMS) {
        const int itB = it + NGW; const bool hasB = itB < NITEMS;
        if (hasB) { decode(itB, dB, nB); t_load(dB, nB, vB, F.lane); }
        t_flush(dA, nA, vA, scr, F.lane);
        if (!hasB) break;
        const int itA = itB + NGW; const bool hasA = itA < NITEMS;
        if (hasA) { decode(itA, dA, nA); t_load(dA, nA, vA, F.lane); }
        t_flush(dB, nB, vB, scr, F.lane);
        it = itA;
    }
}

__device__ __forceinline__ float mod_value(const Args& a, int b, int n) {
    const float* mp = (const float*)(a.ws + WS_MODP) + (size_t)b * 6144 + n; float s = a.b_ada[n];
#pragma unroll
    for (int kg = 0; kg < 8; ++kg) s += mp[(size_t)kg * 4 * 6144];
    return s;
}
__device__ __forceinline__ void p1_adaln(const Frame& F, const Args& a) {
    LAS float* tA = (LAS float*)F.lds; LAS float* tC = tA + DM;
    float* mod = (float*)(a.ws + WS_MOD);
    for (int i = F.vcu * 512 + F.tid; i < 4 * 6144; i += F.G * 512) mod[i] = mod_value(a, i / 6144, i % 6144);
    for (int chunk = F.vcu; chunk < NT / 64; chunk += F.G) {
        const int r0 = chunk * 64, b = r0 / SEQ;
        __syncthreads();
        for (int col = F.tid; col < DM; col += 512) { tA[col] = a.g_pre_mix[col] * (1.0f + mod_value(a, b, DM + col)); tC[col] = mod_value(a, b, col); }
        __syncthreads();
        f32x4 ta[4], tc[4];
#pragma unroll
        for (int j = 0; j < 4; ++j) { ta[j] = *(const LAS f32x4*)(tA + 256 * j + 4 * F.lane); tc[j] = *(const LAS f32x4*)(tC + 256 * j + 4 * F.lane); }
        for (int r = r0 + F.wave; r < r0 + 64; r += NWAVES) {
            const f32x4* xr = (const f32x4*)(a.x + (size_t)r * DM) + F.lane; f32x4 v[4]; float s = 0.f;
#pragma unroll
            for (int j = 0; j < 4; ++j) { v[j] = xr[64 * j]; s += (v[j][0] * v[j][0] + v[j][1] * v[j][1]) + (v[j][2] * v[j][2] + v[j][3] * v[j][3]); }
            const float rstd = 1.0f / sqrtf(wave_sum(s) * (1.0f / DM) + RMS_EPS);
            u32x2* o8 = (u32x2*)((bf16_t*)(a.ws + WS_H) + (size_t)r * DM) + F.lane;
#pragma unroll
            for (int j = 0; j < 4; ++j) { const f32x4 h = v[j] * rstd * ta[j] + tc[j]; u32x2 w; w.x = pk2(h[0], h[1]); w.y = pk2(h[2], h[3]); o8[64 * j] = w; }
        }
    }
}

constexpr int ATT_KSTR = 128, ATT_VSTR = 192, ATT_ROWS = 384;
constexpr int ATT_K_OFF = 0, ATT_V_OFF = ATT_ROWS * ATT_KSTR;
typedef short v4i16_t __attribute__((ext_vector_type(4)));
__device__ __forceinline__ int crow(int r, int hi) { return (r & 3) + 8 * (r >> 2) + 4 * hi; }
__device__ __forceinline__ void attn_item(const Frame& F, const Args& a, int it) {
    const int grp = it >> 8, rem = it & 255, sh = 2 * grp, dil = 1 << sh, nqc = 16 >> sh, sublen = SEQ >> sh;
    const int qc = rem % nqc, r_ = (rem / nqc) % dil, bh = rem / (nqc * dil), hh = bh & 3, b = bh >> 2;
    const int head = grp * 4 + hh, q0 = qc * 256;
    const size_t headbase = ((size_t)(b * NHEAD + head) * SEQ + (size_t)r_ * sublen) * HD;
    const bf16_t* Qh = (const bf16_t*)(a.ws + WS_QS) + headbase;
    const bf16_t* Kh = (const bf16_t*)(a.ws + WS_KS) + headbase;
    const bf16_t* Vh = (const bf16_t*)(a.ws + WS_VS) + headbase;
    LAS unsigned char* sK = F.lds + ATT_K_OFF; LAS unsigned char* sV = F.lds + ATT_V_OFF;
    __syncthreads();
#pragma unroll
    for (int i = 0; i < 6; ++i) { const int idx = F.tid + i * 512, row = idx >> 3, ch = idx & 7; const int ks = q0 - 128 + row;
        u32x4 kv = {0u, 0u, 0u, 0u}, vv = {0u, 0u, 0u, 0u};
        if (ks >= 0) { kv = *(const u32x4*)(Kh + (size_t)ks * HD + ch * 8); vv = *(const u32x4*)(Vh + (size_t)ks * HD + ch * 8); }
        *(LAS u32x4*)(sK + row * ATT_KSTR + ((ch ^ (row & 7)) << 4)) = kv;
        *(LAS u32x4*)(sV + row * ATT_VSTR + (ch << 4)) = vv; }
    const int l = F.lane, l31 = l & 31, hi = l >> 5, w = F.wave;
    bf16x8 qf[4];
#pragma unroll
    for (int ds = 0; ds < 4; ++ds) qf[ds] = *(const bf16x8*)(Qh + (size_t)(q0 + 32 * w + l31) * HD + 16 * ds + 8 * hi);
    __syncthreads();
    const float slope2 = __builtin_amdgcn_exp2f(-8.0f * (float)(head + 1) / 12.0f) * LOG2E * (float)dil;
    const int kbase_sub = q0 - 128 + 32 * w;
    float mx = -INFINITY, lsum = 0.f;
    f32x16 o[2];
    o[0] = (f32x16){0.f, 0.f, 0.f, 0.f, 0.f, 0.f, 0.f, 0.f, 0.f, 0.f, 0.f, 0.f, 0.f, 0.f, 0.f, 0.f}; o[1] = o[0];
    const int g16 = l >> 4, q4 = (l & 15) >> 2, p4 = l & 3;
    const LAS unsigned char* vlane = sV + (32 * w + 4 * (g16 >> 1) + q4) * ATT_VSTR + (16 * (g16 & 1) + 4 * p4) * 2;
#pragma unroll
    for (int jj = 0; jj < 5; ++jj) { const int j = 4 - jj;
        f32x16 st = {0.f, 0.f, 0.f, 0.f, 0.f, 0.f, 0.f, 0.f, 0.f, 0.f, 0.f, 0.f, 0.f, 0.f, 0.f, 0.f};
        const int row = 32 * w + 32 * j + l31;
#pragma unroll
        for (int ds = 0; ds < 4; ++ds) { const bf16x8 kf = *(const LAS bf16x8*)(sK + row * ATT_KSTR + (((2 * ds + hi) ^ (row & 7)) << 4));
            st = __builtin_amdgcn_mfma_f32_32x32x16_bf16(kf, qf[ds], st, 0, 0, 0); }
        float tmax = -INFINITY;
#pragma unroll
        for (int r = 0; r < 16; ++r) { const int kk = 32 * j + crow(r, hi); const int delta = 128 + l31 - kk;
            const bool valid = (delta >= 0) && (delta <= 128) && (kbase_sub + kk >= 0);
            const float sv = valid ? st[r] - slope2 * (float)delta : -INFINITY; st[r] = sv; tmax = fmaxf(tmax, sv); }
        tmax = max_xor32(tmax);
        const float mnew = fmaxf(mx, tmax);
        const float alpha = __builtin_amdgcn_exp2f(mx - mnew);
        mx = mnew; lsum *= alpha;
#pragma unroll
        for (int r = 0; r < 16; ++r) { o[0][r] *= alpha; o[1][r] *= alpha; }
        float psum = 0.f;
#pragma unroll
        for (int r = 0; r < 16; ++r) { const float p = __builtin_amdgcn_exp2f(st[r] - mx); st[r] = p; psum += p; }
        lsum += psum;
#pragma unroll
        for (int s2 = 0; s2 < 2; ++s2) {
            u32x4 pw; pw.x = pk2(st[8 * s2 + 0], st[8 * s2 + 1]); pw.y = pk2(st[8 * s2 + 2], st[8 * s2 + 3]);
            pw.z = pk2(st[8 * s2 + 4], st[8 * s2 + 5]); pw.w = pk2(st[8 * s2 + 6], st[8 * s2 + 7]);
            const bf16x8 pb = __builtin_bit_cast(bf16x8, pw);
#pragma unroll
            for (int dt = 0; dt < 2; ++dt) {
                const LAS unsigned char* vp = vlane + (32 * j + 16 * s2) * ATT_VSTR + dt * 64;
                const s16x4 v0 = __builtin_bit_cast(s16x4, __builtin_amdgcn_ds_read_tr16_b64_v4i16((LAS v4i16_t*)vp));
                const s16x4 v1 = __builtin_bit_cast(s16x4, __builtin_amdgcn_ds_read_tr16_b64_v4i16((LAS v4i16_t*)(vp + 8 * ATT_VSTR)));
                const bf16x8 va = {v0[0], v0[1], v0[2], v0[3], v1[0], v1[1], v1[2], v1[3]};
                o[dt] = __builtin_amdgcn_mfma_f32_32x32x16_bf16(va, pb, o[dt], 0, 0, 0);
            }
        }
    }
    lsum = sum_xor32(lsum);
    const float rl = 1.0f / lsum;
    const int qsub = q0 + 32 * w + l31; const int tok = b * SEQ + qsub * dil + r_;
    bf16_t* og = (grp == 0 ? (bf16_t*)(a.ws + WS_OG0) : (bf16_t*)(a.ws + WS_OG12) + (size_t)(grp - 1) * NT * 256) + (size_t)tok * 256 + hh * 64;
#pragma unroll
    for (int dt = 0; dt < 2; ++dt)
#pragma unroll
        for (int rq = 0; rq < 4; ++rq) { u32x2 wv; wv.x = pk2(o[dt][4 * rq + 0] * rl, o[dt][4 * rq + 1] * rl); wv.y = pk2(o[dt][4 * rq + 2] * rl, o[dt][4 * rq + 3] * rl);
            *(u32x2*)(og + 32 * dt + 8 * rq + 4 * hi) = wv; }
    if (hi == 0) ((float*)(a.ws + WS_LSE))[((size_t)grp * NT + tok) * 4 + hh] = mx + __builtin_amdgcn_logf(lsum);
}
__device__ __forceinline__ void pool_item(const Frame& F, const Args& a, int it) {
    const int t0 = it * 64; const int tl0 = t0 % SEQ;
    const bf16_t* U = (const bf16_t*)(a.ws + WS_U);
    LAS unsigned* su = (LAS unsigned*)F.lds;
    __syncthreads();
    for (int i = F.tid; i < 79 * 256; i += 512) { const int row = i >> 8, cp = i & 255; const int tl = tl0 - 15 + row;
        su[i] = tl >= 0 ? *(const unsigned*)(U + (size_t)(t0 - 15 + row) * POOLW + 2 * cp) : 0u; }
    __syncthreads();
    const int cp = F.tid & 255, half = F.tid >> 8; const int g = cp >> 6; const int wdw = 2 << g;
    float s0 = 0.f, s1 = 0.f;
    const int tb = 32 * half;
    for (int i = 1; i < wdw; ++i) { const unsigned v = su[(15 + tb - i) * 256 + cp]; s0 += bf_lo(v); s1 += bf_hi(v); }
    bf16_t* P = (bf16_t*)(a.ws + WS_POOLED);
    for (int t = tb; t < tb + 32; ++t) {
        const unsigned v = su[(15 + t) * 256 + cp]; const float u0 = bf_lo(v), u1 = bf_hi(v);
        s0 += u0; s1 += u1;
        const int tl = tl0 + t; const float inv = 1.0f / (float)(tl + 1 < wdw ? tl + 1 : wdw);
        *(unsigned*)(P + (size_t)(t0 + t) * POOLW + 2 * cp) = pk2(s0 * inv - u0, s1 * inv - u1);
        const unsigned vo = su[(15 + t - wdw + 1) * 256 + cp]; s0 -= bf_lo(vo); s1 -= bf_hi(vo);
    }
}
__device__ __forceinline__ void combine_rows(const Frame& F, const Args& a) {
    const int gw = F.vcu * NWAVES + F.wave, NGW = F.G * NWAVES;
    const float* LSE = (const float*)(a.ws + WS_LSE);
    const bf16_t* og0 = (const bf16_t*)(a.ws + WS_OG0); const bf16_t* og1 = (const bf16_t*)(a.ws + WS_OG12); const bf16_t* og2 = og1 + (size_t)NT * 256;
    bf16_t* OC = (bf16_t*)(a.ws + WS_OC);
    for (int r = gw; r < NT; r += NGW) {
        const int hh = F.lane >> 4;
        const float l0 = LSE[(size_t)r * 4 + hh], l1 = LSE[((size_t)NT + r) * 4 + hh], l2 = LSE[((size_t)2 * NT + r) * 4 + hh];
        const float m = fmaxf(l0, fmaxf(l1, l2));
        float w0 = __builtin_amdgcn_exp2f(l0 - m), w1 = __builtin_amdgcn_exp2f(l1 - m), w2 = __builtin_amdgcn_exp2f(l2 - m);
        const float inv = 1.0f / (w0 + w1 + w2); w0 *= inv; w1 *= inv; w2 *= inv;
        const u32x2 a0 = *(const u32x2*)(og0 + (size_t)r * 256 + 4 * F.lane), a1 = *(const u32x2*)(og1 + (size_t)r * 256 + 4 * F.lane), a2 = *(const u32x2*)(og2 + (size_t)r * 256 + 4 * F.lane);
        u32x2 o;
        o.x = pk2(w0 * bf_lo(a0.x) + w1 * bf_lo(a1.x) + w2 * bf_lo(a2.x), w0 * bf_hi(a0.x) + w1 * bf_hi(a1.x) + w2 * bf_hi(a2.x));
        o.y = pk2(w0 * bf_lo(a0.y) + w1 * bf_lo(a1.y) + w2 * bf_lo(a2.y), w0 * bf_hi(a0.y) + w1 * bf_hi(a1.y) + w2 * bf_hi(a2.y));
        *(u32x2*)(OC + (size_t)r * 256 + 4 * F.lane) = o;
    }
}

constexpr int WR_STRIDE = 1028;
constexpr int P7_WR_OFF = 0, P7_TAB_OFF = 36 * WR_STRIDE * 4;
constexpr int P7_ASG_OFF = P7_TAB_OFF + 3 * DM * 4;
constexpr int P7_HIST_OFF = P7_ASG_OFF + 64 * 24;
static_assert(P7_HIST_OFF + 256 <= SEG_OFF, "P7 LDS map");
__device__ __forceinline__ void p7_router(const Frame& F, const Args& a) {
    LAS float* sW = (LAS float*)(F.lds + P7_WR_OFF);
    LAS float* tA1 = (LAS float*)(F.lds + P7_TAB_OFF); LAS float* tA2 = tA1 + DM; LAS float* tC2 = tA2 + DM;
    LAS int* asg = (LAS int*)(F.lds + P7_ASG_OFF); LAS int* hist = (LAS int*)(F.lds + P7_HIST_OFF); LAS int* hbase = hist + 32;
    const float* mod = (const float*)(a.ws + WS_MOD);
    __syncthreads();
    for (int i = F.tid; i < DM * 4; i += 512) { const int k = i >> 2, j = i & 3; sW[j * WR_STRIDE + k] = a.w_group_router[i]; }
    for (int i = F.tid; i < DM * 32; i += 512) { const int k = i >> 5, j = i & 31; sW[(4 + j) * WR_STRIDE + k] = a.w_expert_router[i]; }
    const bf16_t* Y = (const bf16_t*)(a.ws + WS_Y); const float* YSTAT = (const float*)(a.ws + WS_YSTAT);
    bf16_t* H2 = (bf16_t*)(a.ws + WS_H2);
    int* gcount = (int*)(a.ws + WS_CTL) + CW_ECOUNT;
    int* LIST_TK = (int*)(a.ws + WS_LIST_TK); float* LIST_W = (float*)(a.ws + WS_LIST_W);
    for (int chunk = F.vcu; chunk < NT / 64; chunk += F.G) {
        const int r0 = chunk * 64, b = r0 / SEQ;
        __syncthreads();
        for (int col = F.tid; col < DM; col += 512) {
            tA1[col] = mod[b * 6144 + 2 * DM + col] * a.g_post_mix[col];
            tA2[col] = a.g_pre_ffn[col] * (1.0f + mod[b * 6144 + 4 * DM + col]);
            tC2[col] = mod[b * 6144 + 3 * DM + col]; }
        if (F.tid < 32) hist[F.tid] = 0;
        __syncthreads();
        for (int rl = F.wave; rl < 64; rl += NWAVES) {
            const int r = r0 + rl;
            float ys = 0.f;
            if (F.lane < 16) ys = YSTAT[(size_t)r * 16 + F.lane];
            ys = wave_sum(ys);
            const float rstd_y = 1.0f / sqrtf(ys * (1.0f / DM) + RMS_EPS);
            const u32x2* yr = (const u32x2*)(Y + (size_t)r * DM) + F.lane; const f32x4* xr = (const f32x4*)(a.x + (size_t)r * DM) + F.lane;
            f32x4 x1[4]; float s1 = 0.f;
#pragma unroll
            for (int j = 0; j < 4; ++j) { const u32x2 yw = yr[64 * j]; const f32x4 xv = xr[64 * j]; const f32x4 t1 = *(const LAS f32x4*)(tA1 + 256 * j + 4 * F.lane);
                f32x4 yv = {bf_lo(yw.x), bf_hi(yw.x), bf_lo(yw.y), bf_hi(yw.y)};
                x1[j] = xv + t1 * yv * rstd_y;
                s1 += (x1[j][0] * x1[j][0] + x1[j][1] * x1[j][1]) + (x1[j][2] * x1[j][2] + x1[j][3] * x1[j][3]); }
            f32x4* xo = (f32x4*)(a.out + (size_t)r * DM) + F.lane;
#pragma unroll
            for (int j = 0; j < 4; ++j) xo[64 * j] = x1[j];
            const float rstd1 = 1.0f / sqrtf(wave_sum(s1) * (1.0f / DM) + RMS_EPS);
            f32x4 h2[4];
            u32x2* ho = (u32x2*)(H2 + (size_t)r * DM) + F.lane;
#pragma unroll
            for (int j = 0; j < 4; ++j) { const f32x4 t2 = *(const LAS f32x4*)(tA2 + 256 * j + 4 * F.lane), c2 = *(const LAS f32x4*)(tC2 + 256 * j + 4 * F.lane);
                h2[j] = x1[j] * rstd1 * t2 + c2; u32x2 w; w.x = pk2(h2[j][0], h2[j][1]); w.y = pk2(h2[j][2], h2[j][3]); ho[64 * j] = w; }
            float lg[36];
#pragma unroll
            for (int c = 0; c < 36; ++c) { float p = 0.f;
#pragma unroll
                for (int j = 0; j < 4; ++j) { const f32x4 wv = *(const LAS f32x4*)(sW + c * WR_STRIDE + 256 * j + 4 * F.lane);
                    p += (h2[j][0] * wv[0] + h2[j][1] * wv[1]) + (h2[j][2] * wv[2] + h2[j][3] * wv[3]); }
                lg[c] = wave_sum(p); }
            float gl[4];
#pragma unroll
            for (int j = 0; j < 4; ++j) gl[j] = lg[j] + a.b_group_router[j];
            int gs = 0; float gm = gl[0];
#pragma unroll
            for (int j = 1; j < 4; ++j) if (gl[j] > gm) { gm = gl[j]; gs = j; }
            float gden = 0.f;
#pragma unroll
            for (int j = 0; j < 4; ++j) gden += __expf(gl[j] - gm);
            const float pg = 1.0f / gden;
            float el[8];
#pragma unroll
            for (int j = 0; j < 8; ++j) { float v = 0.f;
#pragma unroll
                for (int g = 0; g < 4; ++g) v = (gs == g) ? lg[4 + g * 8 + j] + a.b_expert_router[g * 8 + j] : v;
                el[j] = v; }
            int i0 = 0; float v0 = el[0];
#pragma unroll
            for (int j = 1; j < 8; ++j) if (el[j] > v0) { v0 = el[j]; i0 = j; }
            int i1 = -1; float v1 = -INFINITY;
#pragma unroll
            for (int j = 0; j < 8; ++j) if (j != i0 && el[j] > v1) { v1 = el[j]; i1 = j; }
            const float e1 = __expf(v1 - v0); const float w0 = pg / (1.0f + e1), w1 = pg * e1 / (1.0f + e1);
            if (F.lane == 0) { const int ex0 = gs * 8 + i0, ex1 = gs * 8 + i1;
                const int k0 = atomicAdd((int*)&hist[ex0], 1), k1 = atomicAdd((int*)&hist[ex1], 1);
                asg[rl * 6 + 0] = ex0; asg[rl * 6 + 1] = ex1; asg[rl * 6 + 2] = k0; asg[rl * 6 + 3] = k1;
                ((LAS float*)asg)[rl * 6 + 4] = w0; ((LAS float*)asg)[rl * 6 + 5] = w1; }
        }
        __syncthreads();
        if (F.tid < 32) hbase[F.tid] = hist[F.tid] ? (int)__hip_atomic_fetch_add(gcount + F.tid, hist[F.tid], RLX_AGENT) : 0;
        __syncthreads();
        if (F.tid < 128) { const int rl = F.tid >> 1, k = F.tid & 1; const int e = asg[rl * 6 + k]; const int pos = hbase[e] + asg[rl * 6 + 2 + k];
            LIST_TK[e * NT + pos] = (r0 + rl) * 2 + k; LIST_W[e * NT + pos] = ((LAS float*)asg)[rl * 6 + 4 + k]; }
    }
}
__device__ __forceinline__ void moe_segments(const Frame& F, const Args& a) {
    LAS int* seg = (LAS int*)(F.lds + SEG_OFF); LAS int* cnt = seg + 40;
    const int* gcount = (const int*)(a.ws + WS_CTL) + CW_ECOUNT;
    __syncthreads();
    if (F.tid < 32) cnt[F.tid] = __hip_atomic_load(gcount + F.tid, RLX_AGENT);
    __syncthreads();
    if (F.tid == 0) { int s = 0; for (int e = 0; e < 32; ++e) { seg[e] = s; s += (cnt[e] + 255) >> 8; } seg[32] = s; }
    __syncthreads();
}
__device__ __forceinline__ int seg_find(const LAS int* seg, int tile) { int e = 0;
#pragma unroll
    for (int s = 16; s >= 1; s >>= 1) if (seg[e + s] <= tile) e += s;
    return e; }
__device__ __forceinline__ int seg_find_uniform(const LAS int* seg, int tile) { int e = 0;
#pragma unroll
    for (int s = 16; s >= 1; s >>= 1) if (__builtin_amdgcn_readfirstlane(seg[e + s]) <= tile) e += s;
    return e; }
__device__ __forceinline__ void p7b_gather(const Frame& F, const Args& a) {
    const LAS int* seg = (const LAS int*)(F.lds + SEG_OFF); const LAS int* cnt = seg + 40;
    const int total = seg[32] * 256;
    const int gw = F.vcu * NWAVES + F.wave, NGW = F.G * NWAVES;
    const int* LIST_TK = (const int*)(a.ws + WS_LIST_TK); const float* LIST_W = (const float*)(a.ws + WS_LIST_W);
    int* STK = (int*)(a.ws + WS_SLOT_TK); float* SW = (float*)(a.ws + WS_SLOT_W);
    const bf16_t* H2 = (const bf16_t*)(a.ws + WS_H2); bf16_t* XS = (bf16_t*)(a.ws + WS_XS);
    for (int R = gw; R < total; R += NGW) {
        const int e = seg_find(seg, R >> 8); const int i = R - seg[e] * 256;
        if (i < cnt[e]) { const int tk = LIST_TK[e * NT + i]; const float w = LIST_W[e * NT + i];
            const u32x4* src = (const u32x4*)(H2 + (size_t)(tk >> 1) * DM) + F.lane; u32x4* dst = (u32x4*)(XS + (size_t)R * DM) + F.lane;
            const u32x4 v0 = src[0], v1 = src[64]; dst[0] = v0; dst[64] = v1;
            if (F.lane == 0) { STK[R] = tk; SW[R] = w; } }
        else if (F.lane == 0) { STK[R] = -1; SW[R] = 0.f; }
    }
}
struct MoeOrder {
    const LAS int* seg; int G, c; long estride;
    __device__ __forceinline__ bool next(int i, pg8::Unit& u) const {
        const long L = (long)i * G + c; if (L >= (long)__builtin_amdgcn_readfirstlane(seg[32]) * 4) return false;
        u.pm = (int)(L >> 2); u.pn = (int)(L & 3); u.boff = (long)seg_find_uniform(seg, u.pm) * estride; return true; }
    __device__ __forceinline__ void a_ready(const pg8::Unit&) const {}
    __device__ __forceinline__ void done(const pg8::Unit&) const {}
};
__device__ __forceinline__ void p10_final(const Frame& F, const Args& a) {
    LAS float* tA = (LAS float*)F.lds;
    const float* mod = (const float*)(a.ws + WS_MOD);
    const bf16_t* C = (const bf16_t*)(a.ws + WS_CONTRIB);
    for (int chunk = F.vcu; chunk < NT / 64; chunk += F.G) {
        const int r0 = chunk * 64, b = r0 / SEQ;
        __syncthreads();
        for (int col = F.tid; col < DM; col += 512) tA[col] = mod[b * 6144 + 5 * DM + col] * a.g_post_ffn[col];
        __syncthreads();
        for (int r = r0 + F.wave; r < r0 + 64; r += NWAVES) {
            const u32x2* c0 = (const u32x2*)(C + (size_t)(2 * r) * DM) + F.lane; const u32x2* c1 = (const u32x2*)(C + (size_t)(2 * r + 1) * DM) + F.lane;
            f32x4* xo = (f32x4*)(a.out + (size_t)r * DM) + F.lane;
            f32x4 y[4], xv[4]; float s = 0.f;
#pragma unroll
            for (int j = 0; j < 4; ++j) { const u32x2 p = c0[64 * j], q = c1[64 * j]; xv[j] = xo[64 * j];
                y[j] = (f32x4){bf_lo(p.x) + bf_lo(q.x), bf_hi(p.x) + bf_hi(q.x), bf_lo(p.y) + bf_lo(q.y), bf_hi(p.y) + bf_hi(q.y)};
                s += (y[j][0] * y[j][0] + y[j][1] * y[j][1]) + (y[j][2] * y[j][2] + y[j][3] * y[j][3]); }
            const float rstd = 1.0f / sqrtf(wave_sum(s) * (1.0f / DM) + RMS_EPS);
#pragma unroll
            for (int j = 0; j < 4; ++j) { const f32x4 t = *(const LAS f32x4*)(tA + 256 * j + 4 * F.lane); xo[64 * j] = xv[j] + t * y[j] * rstd; }
        }
    }
}

__global__ void __launch_bounds__(NWAVES * 64, 2) fwd_megakernel(Args args) {
    extern __shared__ __attribute__((aligned(16))) unsigned char lds_raw[];
    Frame F; const Args* ap;
#define FRAME() do { ap = (const Args*)__builtin_amdgcn_kernarg_segment_ptr(); asm volatile("" : "+s"(ap)); \
        int t_ = wave_s * 64 + lane_id_asm(); \
        F.lds = (LAS unsigned char*)lds_raw; F.tid = t_; F.lane = t_ & 63; F.wave = wave_s; \
        F.G = gridDim.x; { const int bx = blockIdx.x; F.vcu = (F.G % 8 == 0) ? (bx % 8) * (F.G / 8) + bx / 8 : bx; } } while (0)
    const int wave_s = __builtin_amdgcn_readfirstlane((int)threadIdx.x >> 6);
    cg::this_grid().sync();
    FRAME();
    volatile LAS unsigned* MISC = (volatile LAS unsigned*)(F.lds + MISC_OFF);
    for (int u = F.tid; u < 128; u += NWAVES * 64) MISC[u] = 0u;
    __syncthreads();
    (void)xcd_barrier_post((unsigned*)(ap->ws + WS_CTL) + CW_BAR, MISC + 8, F.tid == 0);
#define GRID_BAR() do { FRAME(); XcdBarrier bar_; bar_.bar = (unsigned*)(ap->ws + WS_CTL) + CW_BAR; bar_.x = xb_xcc_id(); bar_.st = (volatile LAS unsigned*)(F.lds + MISC_OFF) + 8; xcd_barrier(bar_, F.tid == 0); } while (0)
#define a (*ap)
    LAS unsigned char* ring = F.lds;

#ifndef PHASE_MASK
#define PHASE_MASK 0xFFFF
#endif
#ifndef TWICE_MASK
#define TWICE_MASK 0
#endif
#define PH(k) for (int rep_ = 0; rep_ < (((TWICE_MASK >> (k)) & 1) ? 2 : 1); ++rep_) if constexpr ((PHASE_MASK >> (k)) & 1) if ((__syncthreads(), true))
    FRAME();
    PH(0) p0_prologue(F, a);
    GRID_BAR();
    FRAME();
    PH(1) p1_adaln(F, a);
    GRID_BAR();
    FRAME();
    PH(2) {   pg8::Gemm g{(const bf16_t*)(a.ws + WS_H), (const bf16_t*)(a.ws + WS_WIN), NT, NIN, DM}; pg8::StaticOrder S; S.init(NT, NIN, F.G, (int)blockIdx.x);
        pg8::EpiProj E{(bf16_t*)(a.ws + WS_U), (bf16_t*)(a.ws + WS_QS), (bf16_t*)(a.ws + WS_G), 0.125f * LOG2E};
        pg8::gemm_phase<pg8::EpiProj, pg8::StaticOrder, true, true>(ring, g, S, E, wave_s); }
    GRID_BAR();
    FRAME();
    PH(3) for (int it = F.vcu; it < 768; it += F.G) attn_item(F, a, it);
    FRAME();
    PH(11) for (int it = F.vcu; it < NT / 64; it += F.G) pool_item(F, a, it);
    GRID_BAR();
    FRAME();
    PH(12) combine_rows(F, a);
    __syncthreads();
    FRAME();
    PH(4) {   pg8::Gemm g{(const bf16_t*)(a.ws + WS_POOLED), (const bf16_t*)(a.ws + WS_WFOLD), NT, DM, POOLW}; pg8::StaticOrder S; S.init(NT, DM, F.G, (int)blockIdx.x);
        pg8::EpiGate1 E{(const bf16_t*)(a.ws + WS_G), (bf16_t*)(a.ws + WS_TMP)};
        pg8::gemm_phase<pg8::EpiGate1, pg8::StaticOrder, true, true>(ring, g, S, E, wave_s); }
    GRID_BAR();
    FRAME();
    PH(5) {   pg8::Gemm g{(const bf16_t*)(a.ws + WS_OC), (const bf16_t*)(a.ws + WS_WBA), NT, DM, 256}; pg8::StaticOrder S; S.init(NT, DM, F.G, (int)blockIdx.x);
        pg8::EpiGate2 E{(const bf16_t*)(a.ws + WS_G), (const bf16_t*)(a.ws + WS_TMP), (bf16_t*)(a.ws + WS_MERGED)};
        pg8::gemm_phase<pg8::EpiGate2, pg8::StaticOrder, true, true>(ring, g, S, E, wave_s); }
    GRID_BAR();
    FRAME();
    PH(6) {   pg8::Gemm g{(const bf16_t*)(a.ws + WS_MERGED), (const bf16_t*)(a.ws + WS_WOUT), NT, DM, DM}; pg8::StaticOrder S; S.init(NT, DM, F.G, (int)blockIdx.x);
        pg8::EpiY E{(bf16_t*)(a.ws + WS_Y), (float*)(a.ws + WS_YSTAT)};
        pg8::gemm_phase<pg8::EpiY, pg8::StaticOrder, true, true>(ring, g, S, E, wave_s); }
    GRID_BAR();
    FRAME();
    PH(7) p7_router(F, a);
    GRID_BAR();
    FRAME();
    PH(13) { moe_segments(F, a);
    p7b_gather(F, a); }
    GRID_BAR();
    FRAME();
    PH(8) {   pg8::Gemm g{(const bf16_t*)(a.ws + WS_XS), (const bf16_t*)(a.ws + WS_W1), XS_ROWS, DM, DM};
        MoeOrder S{(const LAS int*)(F.lds + SEG_OFF), F.G, (int)blockIdx.x, (long)DM * DM};
        pg8::EpiAct E{(bf16_t*)(a.ws + WS_ACT)};
        pg8::gemm_phase<pg8::EpiAct, MoeOrder, true, true>(ring, g, S, E, wave_s); }
    GRID_BAR();
    FRAME();
    PH(9) {   pg8::Gemm g{(const bf16_t*)(a.ws + WS_ACT), (const bf16_t*)(a.ws + WS_W2), XS_ROWS, DM, DEXP};
        MoeOrder S{(const LAS int*)(F.lds + SEG_OFF), F.G, (int)blockIdx.x, (long)DM * DEXP};
        pg8::EpiDown E{(const int*)(a.ws + WS_SLOT_TK), (const float*)(a.ws + WS_SLOT_W), (bf16_t*)(a.ws + WS_CONTRIB)};
        pg8::gemm_phase<pg8::EpiDown, MoeOrder, true, true>(ring, g, S, E, wave_s); }
    GRID_BAR();
    FRAME();
    if constexpr (DIAG != 1 && DIAG != 2) p10_final(F, a);
#undef a
}

extern "C" void kernel_launch(void* const* d_in, const int* in_sizes, int n_in, void* d_out, int out_size, void* d_ws, size_t ws_size, hipStream_t stream) {
    static int grid = 0;
    if (grid == 0) {
        if (n_in != 21 || in_sizes[0] != NT * DM || out_size != NT * DM || ws_size < WS_END) {
            fprintf(stderr, "kernel_launch: unexpected shapes: n_in %d in0 %d out %d ws %zu (need %zu)\n", n_in, n_in > 0 ? in_sizes[0] : -1, out_size, ws_size, (size_t)WS_END); grid = -1; return; }
        int dev = 0, cus = 0, per_cu = 0;
        hipGetDevice(&dev);
        hipDeviceGetAttribute(&cus, hipDeviceAttributeMultiprocessorCount, dev);
        if (hipFuncSetAttribute((const void*)fwd_megakernel, hipFuncAttributeMaxDynamicSharedMemorySize, LDS_BYTES) != hipSuccess) { fprintf(stderr, "kernel_launch: hipFuncSetAttribute(%d) failed\n", LDS_BYTES); (void)hipGetLastError(); }
        if (hipOccupancyMaxActiveBlocksPerMultiprocessor(&per_cu, (const void*)fwd_megakernel, NWAVES * 64, LDS_BYTES) != hipSuccess || per_cu < 1) {
            fprintf(stderr, "kernel_launch: occupancy query says %d blocks per CU\n", per_cu); (void)hipGetLastError(); per_cu = 1; }
        grid = cus;
        if (grid > 256) grid = 256;
        fprintf(stderr, "kernel_launch: cus %d per_cu %d grid %d\n", cus, per_cu, grid);
    }
    if (grid < 0) return;
    hipMemsetAsync((char*)d_ws + WS_CTL, 0, CTL_ZERO_BYTES, stream);
    Args a{};
    const float** p = (const float**)&a;
    for (int i = 0; i < 21; ++i) p[i] = (const float*)d_in[i];
    a.out = (float*)d_out; a.ws = (unsigned char*)d_ws;
    void* kargs[] = {&a};
    hipError_t e = hipLaunchCooperativeKernel((const void*)fwd_megakernel, dim3(grid), dim3(NWAVES * 64), kargs, LDS_BYTES, stream);
    if (e != hipSuccess) fprintf(stderr, "kernel_launch: cooperative launch failed: %s (grid %d)\n", hipGetErrorString(e), grid);
}
```
